# Optimizing an MI355X kernel written in HIP

```python
import math
import jax
import jax.numpy as jnp
from jax import lax
import numpy as np

D_MODEL = 1024
BATCH = 16
SEQ = 2048
DEPTH = 1

CHUNK = 64
Q_BLOCK = 128
DA_HEADS = 8
DA_HEAD_DIM = D_MODEL // (2 * DA_HEADS)
DA_WIDTH = DA_HEADS * 2 * DA_HEAD_DIM
ML_HEADS = 8
ML_WIDTH = D_MODEL
ML_HEAD_DIM = ML_WIDTH // ML_HEADS
CONV_K = 4
N_BUCKETS = 32
MAX_DISTANCE = 128
NORM_EPS = 1e-6
SUBLN_EPS = 1e-5
HEAD_LN_EPS = 1e-5
NEG_INF = -1e30
IN_SIZES = (DA_WIDTH, DA_WIDTH, DA_WIDTH, DA_WIDTH,
            ML_WIDTH, ML_WIDTH, ML_WIDTH, ML_WIDTH, ML_WIDTH,
            ML_HEADS, ML_HEADS, D_MODEL, D_MODEL)
D_IN = 4 * DA_WIDTH + 5 * ML_WIDTH + 2 * ML_HEADS + 2 * D_MODEL

kernel_name = "hybrid_diffattn_mlstm_gated_block"


def _rmsnorm(x, w, eps=NORM_EPS):
    xf = x.astype(jnp.float32)
    y = xf * lax.rsqrt(jnp.mean(xf * xf, axis=-1, keepdims=True) + eps)
    return (y * w.astype(jnp.float32)).astype(x.dtype)


def _split_columns(w):
    offsets = [int(o) for o in np.cumsum(IN_SIZES)[:-1]]
    return jnp.split(w, offsets, axis=-1)


def _rel_bucket(rel):
    nb = N_BUCKETS // 2
    max_exact = nb // 2
    bucket = jnp.where(rel > 0, nb, 0)
    n = jnp.abs(rel)
    nf = jnp.maximum(n, 1).astype(jnp.float32)
    large = max_exact + (jnp.log(nf / max_exact) / math.log(MAX_DISTANCE / max_exact)
                         * (nb - max_exact)).astype(jnp.int32)
    large = jnp.minimum(large, nb - 1)
    return bucket + jnp.where(n < max_exact, n, large)


def _diff_attention(q, k, v, lam_vecs, subln_w, rel_bias, lambda_init):
    b, s, _ = q.shape
    out_dtype = q.dtype
    q = (q.reshape(b, s, DA_HEADS, 2, DA_HEAD_DIM) * DA_HEAD_DIM ** -0.5).transpose(3, 0, 2, 1, 4)
    k = k.reshape(b, s, DA_HEADS, 2, DA_HEAD_DIM).transpose(3, 0, 2, 1, 4)
    v = v.reshape(b, s, DA_HEADS, 2 * DA_HEAD_DIM).transpose(0, 2, 1, 3).astype(jnp.float32)
    lf = lam_vecs.astype(jnp.float32)
    lam = jnp.exp(jnp.sum(lf[0] * lf[1])) - jnp.exp(jnp.sum(lf[2] * lf[3])) + lambda_init
    kpos = jnp.arange(s)

    def block(i):
        q0 = i * Q_BLOCK
        qb = lax.dynamic_slice_in_dim(q, q0, Q_BLOCK, axis=3)
        qpos = q0 + jnp.arange(Q_BLOCK)
        bias = rel_bias[_rel_bucket(kpos[None, :] - qpos[:, None])]
        bias = bias.astype(jnp.float32).transpose(2, 0, 1)
        mask = (kpos[None, :] // CHUNK) <= (qpos[:, None] // CHUNK)
        logits = jnp.einsum("pbhqd,pbhkd->pbhqk", qb, k).astype(jnp.float32) + bias
        probs = jax.nn.softmax(jnp.where(mask, logits, NEG_INF), axis=-1)
        attn = probs[0] - lam * probs[1]
        return jnp.einsum("bhqk,bhkv->bhqv", attn, v)

    out = lax.map(block, jnp.arange(s // Q_BLOCK))
    out = out.transpose(1, 2, 0, 3, 4).reshape(b, DA_HEADS, s, 2 * DA_HEAD_DIM)
    out = _rmsnorm(out, subln_w, SUBLN_EPS) * (1.0 - lambda_init)
    return out.transpose(0, 2, 1, 3).reshape(b, s, DA_WIDTH).astype(out_dtype)


def _causal_conv(u, w, bias):
    s = u.shape[1]
    up = jnp.pad(u, ((0, 0), (CONV_K - 1, 0), (0, 0)))
    out = bias
    for j in range(CONV_K):
        out = out + w[j] * up[:, j:j + s, :]
    return out


def _mlstm_chunk(carry, inp):
    c_state, n_state, m_state = carry
    q, k, v, ig, lf = inp
    q = q.astype(jnp.float32)
    k = k.astype(jnp.float32)
    v = v.astype(jnp.float32)
    b = jnp.cumsum(lf, axis=-1)
    causal = jnp.arange(CHUNK)[:, None] >= jnp.arange(CHUNK)[None, :]
    d_log = jnp.where(causal, b[..., :, None] - b[..., None, :] + ig[..., None, :], NEG_INF)
    inter = b + m_state[..., None]
    m_t = jnp.maximum(inter, jnp.max(d_log, axis=-1))
    w_intra = jnp.exp(d_log - m_t[..., None])
    w_inter = jnp.exp(inter - m_t)
    scores = jnp.einsum("bhtd,bhsd->bhts", q, k) * w_intra
    num = (jnp.einsum("bhts,bhsv->bhtv", scores, v)
           + w_inter[..., None] * jnp.einsum("bhtd,bhdv->bhtv", q, c_state))
    den = jnp.sum(scores, axis=-1) + w_inter * jnp.einsum("bhtd,bhd->bht", q, n_state)
    h = num / jnp.maximum(jnp.abs(den), jnp.exp(-m_t))[..., None]
    b_last = b[..., -1]
    w_log = b_last[..., None] - b + ig
    m_new = jnp.maximum(b_last + m_state, jnp.max(w_log, axis=-1))
    w_s = jnp.exp(w_log - m_new[..., None])
    decay = jnp.exp(b_last + m_state - m_new)
    c_new = decay[..., None, None] * c_state + jnp.einsum("bhs,bhsd,bhsv->bhdv", w_s, k, v)
    n_new = decay[..., None] * n_state + jnp.einsum("bhs,bhsd->bhd", w_s, k)
    return (c_new, n_new, m_new), h


def _mlstm(q, k, v, ig, fg, o, conv_w, conv_b, b_if, mh_w):
    b, s, _ = q.shape
    nc = s // CHUNK
    out_dtype = v.dtype
    q = jax.nn.silu(_causal_conv(q, conv_w[0], conv_b[0]))
    k = jax.nn.silu(_causal_conv(k, conv_w[1], conv_b[1])) * ML_HEAD_DIM ** -0.5

    def heads_to_chunks(u):
        return u.reshape(b, nc, CHUNK, ML_HEADS, ML_HEAD_DIM).transpose(1, 0, 3, 2, 4)

    def gates_to_chunks(g):
        return g.reshape(b, nc, CHUNK, ML_HEADS).transpose(1, 0, 3, 2)

    ig_c = gates_to_chunks((ig + b_if[0]).astype(jnp.float32))
    lf_c = gates_to_chunks(jax.nn.log_sigmoid((fg + b_if[1]).astype(jnp.float32)))
    init = (jnp.zeros((b, ML_HEADS, ML_HEAD_DIM, ML_HEAD_DIM), jnp.float32),
            jnp.zeros((b, ML_HEADS, ML_HEAD_DIM), jnp.float32),
            jnp.zeros((b, ML_HEADS), jnp.float32))
    _, h = lax.scan(_mlstm_chunk, init,
                    (heads_to_chunks(q), heads_to_chunks(k), heads_to_chunks(v), ig_c, lf_c))
    h = h.transpose(1, 0, 3, 2, 4).reshape(b, s, ML_HEADS, ML_HEAD_DIM)
    mu = jnp.mean(h, axis=-1, keepdims=True)
    var = jnp.mean(jnp.square(h - mu), axis=-1, keepdims=True)
    hn = (h - mu) * lax.rsqrt(var + HEAD_LN_EPS) * mh_w.astype(jnp.float32).reshape(ML_HEADS, ML_HEAD_DIM)
    return (jax.nn.sigmoid(o.astype(jnp.float32)) * hn.reshape(b, s, ML_WIDTH)).astype(out_dtype)


def _normal(key, shape, scale):
    return scale * jax.random.normal(key, shape, jnp.float32)


def setup_inputs(seed: int = 0) -> dict:
    key = jax.random.key(seed)
    ks = jax.random.split(key, 18)
    b_if = jnp.stack([
        _normal(ks[8], (DEPTH, ML_HEADS), 0.1),
        jnp.linspace(3.0, 6.0, ML_HEADS, dtype=jnp.float32)[None, :] + _normal(ks[9], (DEPTH, ML_HEADS), 0.1),
    ], axis=1)
    return {
        "x": _normal(ks[0], (BATCH, SEQ, D_MODEL), 1.0),
        "norm_w": 1.0 + _normal(ks[1], (DEPTH, D_MODEL), 0.02),
        "w_in": _normal(ks[2], (DEPTH, D_MODEL, D_IN), D_MODEL ** -0.5),
        "lam": _normal(ks[3], (DEPTH, 4, DA_HEAD_DIM), 0.1),
        "subln_w": 1.0 + _normal(ks[4], (DEPTH, 2 * DA_HEAD_DIM), 0.02),
        "rel_bias": _normal(ks[5], (N_BUCKETS, DA_HEADS), 0.1),
        "conv_w": _normal(ks[6], (DEPTH, 2, CONV_K, ML_WIDTH), CONV_K ** -0.5),
        "conv_b": _normal(ks[7], (DEPTH, 2, ML_WIDTH), 0.02),
        "b_if": b_if,
        "mh_w": 1.0 + _normal(ks[10], (DEPTH, ML_WIDTH), 0.02),
        "b_gate": _normal(ks[11], (DEPTH, 2, D_MODEL), 0.02),
        "w_pa": _normal(ks[12], (DEPTH, DA_WIDTH, D_MODEL), DA_WIDTH ** -0.5),
        "w_pm": _normal(ks[13], (DEPTH, ML_WIDTH, D_MODEL), ML_WIDTH ** -0.5),
        "w_out": _normal(ks[14], (DEPTH, D_MODEL, D_MODEL), D_MODEL ** -0.5),
        "norm_final": 1.0 + _normal(ks[15], (D_MODEL,), 0.02),
    }


def reference(x, norm_w, w_in, lam, subln_w, rel_bias, conv_w, conv_b, b_if, mh_w,
              b_gate, w_pa, w_pm, w_out, norm_final):
    h = x
    for layer in range(DEPTH):
        lambda_init = 0.8 - 0.6 * math.exp(-0.3 * layer)
        xn = _rmsnorm(h, norm_w[layer])
        (da_q, da_k, da_v, da_z, ml_q, ml_k, ml_v, ml_o, ml_z, ml_i, ml_f,
         gate_a, gate_m) = [xn @ wp for wp in _split_columns(w_in[layer])]
        y_a = _diff_attention(da_q, da_k, da_v, lam[layer], subln_w[layer], rel_bias,
                              lambda_init) * jax.nn.silu(da_z)
        y_m = _mlstm(ml_q, ml_k, ml_v, ml_i, ml_f, ml_o, conv_w[layer], conv_b[layer],
                     b_if[layer], mh_w[layer]) * jax.nn.silu(ml_z)
        g_a = jax.nn.sigmoid(gate_a + b_gate[layer, 0])
        g_m = jax.nn.sigmoid(gate_m + b_gate[layer, 1])
        merged = g_a * (y_a @ w_pa[layer]) + g_m * (y_m @ w_pm[layer])
        h = h + merged @ w_out[layer]
    return _rmsnorm(h, norm_final)
```

```cpp
#include <hip/hip_runtime.h>
#include <hip/hip_cooperative_groups.h>
#include <cstdio>
#include <cstdint>
#ifndef DBG
#define DBG 0
#endif
#ifndef NAIVE_ATTN
#define NAIVE_ATTN 0
#endif
#ifndef NAIVE_MLSTM
#define NAIVE_MLSTM 0
#endif
#ifndef ONE_LAUNCH
#define ONE_LAUNCH 1
#endif
#ifndef USE_CG_SYNC
#define USE_CG_SYNC 1
#endif
#ifndef CG_FIRST
#define CG_FIRST 1
#endif
#ifndef SELFCHECK
#define SELFCHECK 0
#endif
namespace pg8 {
#define PG8_LAS __attribute__((address_space(3)))
typedef unsigned short bf16_t;
typedef short bf16x8 __attribute__((ext_vector_type(8)));
typedef float f32x4 __attribute__((ext_vector_type(4)));
typedef unsigned u32x4 __attribute__((ext_vector_type(4)));
constexpr int BM = 256, BK = 64, HALF = 128, HTB = HALF * BK * 2  , STAGE_BYTES = 8 * HTB, NXCD = 8, WGM = 8;

__host__ __device__ __forceinline__ int lds_byte(int r, int c) { const int st = (r >> 4) * 2 + (c >> 5), rr = r & 15, cc = c & 31, ob = rr * 64 + cc * 2; return st * 1024 + (ob ^ (((ob >> 9) & 1) << 5)); }
__host__ __device__ __forceinline__ void stage_rc(int b, int& R, int& C) { const int st = b / 1024, sb = b % 1024, swz = sb ^ (((sb >> 9) & 1) << 5); R = (st >> 1) * 16 + swz / 64; C = (st & 1) * 32 + (swz % 64) / 2; }
__host__ __device__ __forceinline__ int perm32(int rho) { const int n = rho >> 4, i = rho & 15; return 8 * (i >> 2) + 4 * n + (i & 3); }

struct Unit { int pm, pn, pb, side; };
struct Gemm { const bf16_t* A; const bf16_t* A1; const bf16_t* A2; const bf16_t* Bt; int M, N, K; };

struct StaticOrder {
    int nM, nN, nwg, G, c;
    __host__ __device__ void init(int M, int N, int G_, int c_) { nM = M / BM; nN = N / BM; nwg = nM * nN; G = G_; c = c_; }
    __host__ __device__ bool next(int i, Unit& u) const {
        const long L = (long)i * G + c; if (L >= nwg) return false;
        int wgid = (int)L; { const int q = nwg / NXCD, r = nwg % NXCD, xcd = wgid % NXCD, off = wgid / NXCD; wgid = (xcd < r ? xcd * (q + 1) : r * (q + 1) + (xcd - r) * q) + off; }
        const int nig = WGM * nN, gid = wgid / nig, fm = gid * WGM, gsz = (nM - fm) < WGM ? (nM - fm) : WGM;
        u.pm = fm + ((wgid % nig) % gsz); u.pn = (wgid % nig) / gsz; u.pb = u.pn; u.side = 0; return true;
    }
    __device__ __forceinline__ void a_ready(const Unit&) const {}
    __device__ __forceinline__ void done(const Unit&) const {}
};


typedef float f32x2_t __attribute__((ext_vector_type(2))); typedef __bf16 bf16x2_t __attribute__((ext_vector_type(2)));
__device__ __forceinline__ unsigned cvt_pk_bf16(float lo, float hi) { f32x2_t v = {lo, hi}; bf16x2_t b = __builtin_convertvector(v, bf16x2_t); return __builtin_bit_cast(unsigned, b); }
__device__ __forceinline__ float sigmoid_f(float x) { return __builtin_amdgcn_rcpf(1.0f + __builtin_amdgcn_exp2f(-1.4426950408889634f * x)); }
__device__ __forceinline__ float silu_f(float x) { return x * sigmoid_f(x); }
__device__ __forceinline__ f32x4 bf4_lo(unsigned a, unsigned b) { return (f32x4){__uint_as_float(a << 16), __uint_as_float(a & 0xffff0000u), __uint_as_float(b << 16), __uint_as_float(b & 0xffff0000u)}; }
__device__ __forceinline__ u32x4 pack8(f32x4 v0, f32x4 v1) { u32x4 w; w.x = cvt_pk_bf16(v0[0], v0[1]); w.y = cvt_pk_bf16(v0[2], v0[3]); w.z = cvt_pk_bf16(v1[0], v1[1]); w.w = cvt_pk_bf16(v1[2], v1[3]); return w; }

struct EpiP1 {
    static constexpr bool PERM = true, AFTER_DRAIN = false;
    bf16_t* g0; size_t gstride; bf16_t* mv; bf16_t* oz; float c2;
    __device__ __forceinline__ void operator()(const f32x4 (&acc)[2][2][4][2], const Unit& u, int wr, int wc, int fr, int fq) const {
        const int row0 = u.pm * BM + wr * 64 + fr;
        if (u.pn < 28) {
            const int g = u.pn >> 2; bf16_t* base = (g < 6) ? g0 + (size_t)g * gstride : mv;
            const int col0 = (u.pn & 3) * BM + wc * 32 + 8 * fq;
            const float sc = (g == 0) ? c2 : 1.0f; const bool act = (g == 3);
#pragma unroll
            for (int ai = 0; ai < 2; ++ai)
#pragma unroll
                for (int m = 0; m < 4; ++m) { bf16_t* rowp = base + (size_t)(row0 + ai * HALF + m * 16) * 1024 + col0;
#pragma unroll
                    for (int bj = 0; bj < 2; ++bj) { f32x4 v0 = acc[ai][bj][m][0] * sc, v1 = acc[ai][bj][m][1] * sc;
                        if (act) {
#pragma unroll
                            for (int e = 0; e < 4; ++e) { v0[e] = silu_f(v0[e]); v1[e] = silu_f(v1[e]); } }
                        *(u32x4*)(rowp + bj * HALF) = pack8(v0, v1); } }
        } else {
            const int col0 = (u.pn - 28) * HALF + wc * 32 + 8 * fq;
#pragma unroll
            for (int ai = 0; ai < 2; ++ai)
#pragma unroll
                for (int m = 0; m < 4; ++m) { bf16_t* rowp = oz + (size_t)(row0 + ai * HALF + m * 16) * 1024 + col0; f32x4 v0, v1;
#pragma unroll
                    for (int e = 0; e < 4; ++e) { v0[e] = sigmoid_f(acc[ai][0][m][0][e]) * silu_f(acc[ai][1][m][0][e]); v1[e] = sigmoid_f(acc[ai][0][m][1][e]) * silu_f(acc[ai][1][m][1][e]); }
                    *(u32x4*)rowp = pack8(v0, v1); }
        }
    }
};
struct EpiGate {
    static constexpr bool PERM = true, AFTER_DRAIN = false;
    bf16_t* ga; size_t gstride; const float* bias;
    __device__ __forceinline__ void operator()(const f32x4 (&acc)[2][2][4][2], const Unit& u, int wr, int wc, int fr, int fq) const {
        const int row0 = u.pm * BM + wr * 64 + fr; const int g = u.pn >> 2; bf16_t* base = ga + (size_t)g * gstride;
        const int col0 = (u.pn & 3) * BM + wc * 32 + 8 * fq;
        f32x4 bv[2][2];
#pragma unroll
        for (int bj = 0; bj < 2; ++bj)
#pragma unroll
            for (int n = 0; n < 2; ++n) bv[bj][n] = *(const f32x4*)(bias + g * 1024 + col0 + bj * HALF + 4 * n);
#pragma unroll
        for (int ai = 0; ai < 2; ++ai)
#pragma unroll
            for (int m = 0; m < 4; ++m) { bf16_t* rowp = base + (size_t)(row0 + ai * HALF + m * 16) * 1024 + col0;
#pragma unroll
                for (int bj = 0; bj < 2; ++bj) { f32x4 v0 = acc[ai][bj][m][0] + bv[bj][0], v1 = acc[ai][bj][m][1] + bv[bj][1];
#pragma unroll
                    for (int e = 0; e < 4; ++e) { v0[e] = sigmoid_f(v0[e]); v1[e] = sigmoid_f(v1[e]); }
                    *(u32x4*)(rowp + bj * HALF) = pack8(v0, v1); } }
    }
};
struct EpiMerge {
    static constexpr bool PERM = true, AFTER_DRAIN = false;
    const bf16_t* ga; const bf16_t* gm; bf16_t* tb; bf16_t* mb;
    __device__ __forceinline__ void operator()(const f32x4 (&acc)[2][2][4][2], const Unit& u, int wr, int wc, int fr, int fq) const {
        const int row0 = u.pm * BM + wr * 64 + fr; const int col0 = u.pn * BM + wc * 32 + 8 * fq;
        const bf16_t* gp = u.side ? gm : ga;
#pragma unroll
        for (int ai = 0; ai < 2; ++ai)
#pragma unroll
            for (int m = 0; m < 4; ++m) { const size_t off = (size_t)(row0 + ai * HALF + m * 16) * 1024 + col0;
#pragma unroll
                for (int bj = 0; bj < 2; ++bj) { const u32x4 gw = *(const u32x4*)(gp + off + bj * HALF);
                    f32x4 v0 = acc[ai][bj][m][0] * bf4_lo(gw.x, gw.y), v1 = acc[ai][bj][m][1] * bf4_lo(gw.z, gw.w);
                    if (u.side) { const u32x4 tw = *(const u32x4*)(tb + off + bj * HALF); if (DBG == 1) { v0 = bf4_lo(tw.x, tw.y); v1 = bf4_lo(tw.z, tw.w); } else if (DBG != 2) { v0 += bf4_lo(tw.x, tw.y); v1 += bf4_lo(tw.z, tw.w); } *(u32x4*)(mb + off + bj * HALF) = pack8(v0, v1); }
                    else *(u32x4*)(tb + off + bj * HALF) = pack8(v0, v1); } }
    }
};
struct EpiRes {
    static constexpr bool PERM = false, AFTER_DRAIN = false;
    const float* base; float* out;
    __device__ __forceinline__ void operator()(const f32x4 (&acc)[2][2][4][2], const Unit& u, int wr, int wc, int fr, int fq) const {
        const int row0 = u.pm * BM + wr * 64 + fr; const int col0 = u.pn * BM + wc * 32 + 4 * fq;
#pragma unroll
        for (int ai = 0; ai < 2; ++ai)
#pragma unroll
            for (int m = 0; m < 4; ++m) { const size_t off = (size_t)(row0 + ai * HALF + m * 16) * 1024 + col0;
#pragma unroll
                for (int bj = 0; bj < 2; ++bj)
#pragma unroll
                    for (int n = 0; n < 2; ++n) { const f32x4 bs = *(const f32x4*)(base + off + bj * HALF + n * 16); *(f32x4*)(out + off + bj * HALF + n * 16) = bs + acc[ai][bj][m][n]; } }
    }
};
struct EpiGM {
    static constexpr bool PERM = true, AFTER_DRAIN = false;
    bf16_t* ga; bf16_t* gm; bf16_t* tb; bf16_t* mb; const float* bias;
    __device__ __forceinline__ void operator()(const f32x4 (&acc)[2][2][4][2], const Unit& u, int wr, int wc, int fr, int fq) const {
        const int row0 = u.pm * BM + wr * 64 + fr; const int col0 = u.pn * BM + wc * 32 + 8 * fq; const int kind = u.pb >> 2;
        if (kind < 2) {
            bf16_t* base = kind ? gm : ga; f32x4 bv[2][2];
#pragma unroll
            for (int bj = 0; bj < 2; ++bj)
#pragma unroll
                for (int n = 0; n < 2; ++n) bv[bj][n] = *(const f32x4*)(bias + kind * 1024 + col0 + bj * HALF + 4 * n);
#pragma unroll
            for (int ai = 0; ai < 2; ++ai)
#pragma unroll
                for (int m = 0; m < 4; ++m) { bf16_t* rowp = base + (size_t)(row0 + ai * HALF + m * 16) * 1024 + col0;
#pragma unroll
                    for (int bj = 0; bj < 2; ++bj) { f32x4 v0 = acc[ai][bj][m][0] + bv[bj][0], v1 = acc[ai][bj][m][1] + bv[bj][1];
#pragma unroll
                        for (int e = 0; e < 4; ++e) { v0[e] = sigmoid_f(v0[e]); v1[e] = sigmoid_f(v1[e]); }
                        *(u32x4*)(rowp + bj * HALF) = pack8(v0, v1); } }
        } else {
            const bf16_t* gp = (kind == 3) ? gm : ga;
#pragma unroll
            for (int ai = 0; ai < 2; ++ai)
#pragma unroll
                for (int m = 0; m < 4; ++m) { const size_t off = (size_t)(row0 + ai * HALF + m * 16) * 1024 + col0;
#pragma unroll
                    for (int bj = 0; bj < 2; ++bj) { const u32x4 gw = *(const u32x4*)(gp + off + bj * HALF);
                        f32x4 v0 = acc[ai][bj][m][0] * bf4_lo(gw.x, gw.y), v1 = acc[ai][bj][m][1] * bf4_lo(gw.z, gw.w);
                        if (kind == 3) { const u32x4 tw = *(const u32x4*)(tb + off + bj * HALF); v0 += bf4_lo(tw.x, tw.y); v1 += bf4_lo(tw.z, tw.w); *(u32x4*)(mb + off + bj * HALF) = pack8(v0, v1); }
                        else *(u32x4*)(tb + off + bj * HALF) = pack8(v0, v1); } }
        }
    }
};
struct QuadOrder {
    StaticOrder so;
    __device__ void init(int M, int N, int G_, int c_) { so.init(M, N, G_, c_); }
    __device__ bool next(int i, Unit& u) const { if (!so.next(i >> 2, u)) return false; const int k = i & 3; u.pb = u.pn + 4 * k; u.side = (k < 2) ? 0 : k - 1; return true; }
    __device__ __forceinline__ void a_ready(const Unit&) const {}
    __device__ __forceinline__ void done(const Unit&) const {}
};
struct PairOrder {
    StaticOrder so;
    __device__ void init(int M, int N, int G_, int c_) { so.init(M, N, G_, c_); }
    __device__ bool next(int i, Unit& u) const { if (!so.next(i >> 1, u)) return false; u.side = i & 1; u.pb = u.pn + (u.side ? so.nN : 0); return true; }
    __device__ __forceinline__ void a_ready(const Unit&) const {}
    __device__ __forceinline__ void done(const Unit&) const {}
};

template <class Epi, class Sched, bool ALIGN_EPI = false, bool SP2 = false>
__device__ __forceinline__ void gemm_phase(PG8_LAS unsigned char* lds, const Gemm g, const Sched& S, const Epi& E) {
    const int tid = threadIdx.x, wid = __builtin_amdgcn_readfirstlane(tid >> 6), lane = tid & 63, wr = wid >> 2, wc = wid & 3, fr = lane & 15, fq = lane >> 4;
    const int K = g.K, nt = K / BK;
    unsigned voffA[2], voffB[2];
#pragma unroll
    for (int i = 0; i < 2; ++i) { int R, C; stage_rc(tid * 16 + i * 8192, R, C); const int Rb = Epi::PERM ? ((R & ~31) + perm32(R & 31)) : R;
        voffA[i] = (unsigned)(R * K + C) * 2u; voffB[i] = (unsigned)(Rb * K + C) * 2u; }
    const size_t kstep = (size_t)(BK * 2);
    const size_t hstep = (size_t)HALF * K * 2;
    const size_t tstep = 2 * hstep;
    const unsigned ldsw = (unsigned)wid * 1024u;
    const int aoff = lds_byte(wr * 64 + fr, fq * 8), boff = lds_byte(wc * 32 + fr, fq * 8);
#define PG8_SA(b, h) (((b) * 2 + (h)) * HTB)
#define PG8_SB(b, h) ((4 + (b) * 2 + (h)) * HTB)
#define PG8_STAGE(bufoff, gbase, voff) do { _Pragma("unroll") for (int _i = 0; _i < 2; ++_i) \
        __builtin_amdgcn_global_load_lds((const unsigned*)((const char*)(gbase) + (voff)[_i]), (PG8_LAS unsigned*)(lds + (bufoff) + ldsw + _i * 8192), 16, 0, 0); } while (0)
#define PG8_LDA(dst, b, h) do { _Pragma("unroll") for (int m = 0; m < 4; ++m) _Pragma("unroll") for (int k = 0; k < 2; ++k) dst[m][k] = *(const PG8_LAS bf16x8*)(lds + PG8_SA(b, h) + aoff + m * 2048 + k * 1024); } while (0)
#define PG8_LDB(dst, b, h) do { _Pragma("unroll") for (int n = 0; n < 2; ++n) _Pragma("unroll") for (int k = 0; k < 2; ++k) dst[n][k] = *(const PG8_LAS bf16x8*)(lds + PG8_SB(b, h) + boff + n * 2048 + k * 1024); } while (0)
#define PG8_MMA(ai, bj, At, Bt) do { __builtin_amdgcn_s_setprio(1); _Pragma("unroll") for (int m = 0; m < 4; ++m) _Pragma("unroll") for (int n = 0; n < 2; ++n) _Pragma("unroll") for (int k = 0; k < 2; ++k) \
        acc[ai][bj][m][n] = __builtin_amdgcn_mfma_f32_16x16x32_bf16(Bt[n][k], At[m][k], acc[ai][bj][m][n], 0, 0, 0); __builtin_amdgcn_s_setprio(0); } while (0)
#define PG8_WAIT_V(n) asm volatile("s_waitcnt vmcnt(" #n ")" ::: "memory")
#define PG8_WAIT_L(n) asm volatile("s_waitcnt lgkmcnt(" #n ")" ::: "memory")
#define PG8_BAR __builtin_amdgcn_s_barrier()
#define PG8_SCHED __builtin_amdgcn_sched_barrier(0)
    Unit cur, nxt; int ui = 0;
    if (!S.next(0, cur)) return;
    f32x4 acc[2][2][4][2];
#pragma unroll
    for (int a = 0; a < 2; ++a)
#pragma unroll
        for (int b = 0; b < 2; ++b)
#pragma unroll
            for (int m = 0; m < 4; ++m)
#pragma unroll
                for (int n = 0; n < 2; ++n) acc[a][b][m][n] = (f32x4){0.f, 0.f, 0.f, 0.f};
    bf16x8 At[4][2], B0[2][2], B1[2][2];
    const char* cA = (const char*)(cur.side == 0 ? g.A : (cur.side == 1 ? g.A1 : g.A2)) + (size_t)cur.pm * tstep; const char* cB = (const char*)g.Bt + (size_t)cur.pb * tstep;
    S.a_ready(cur);
    if constexpr (SP2) {
        PG8_STAGE(PG8_SB(0, 0), cB, voffB); PG8_STAGE(PG8_SB(0, 1), cB + hstep, voffB); PG8_STAGE(PG8_SA(0, 0), cA, voffA); PG8_STAGE(PG8_SA(0, 1), cA + hstep, voffA);
        if (wr == 1) PG8_BAR;
        PG8_WAIT_V(2); PG8_BAR;
        PG8_STAGE(PG8_SB(1, 0), cB + kstep, voffB); PG8_STAGE(PG8_SA(1, 0), cA + kstep, voffA); PG8_STAGE(PG8_SB(1, 1), cB + hstep + kstep, voffB);
        PG8_WAIT_V(6); PG8_BAR;
    } else {
        PG8_STAGE(PG8_SB(0, 0), cB, voffB); PG8_STAGE(PG8_SA(0, 0), cA, voffA); PG8_STAGE(PG8_SB(0, 1), cB + hstep, voffB); PG8_STAGE(PG8_SA(0, 1), cA + hstep, voffA);
        if (wr == 1) PG8_BAR;
        PG8_WAIT_V(4); PG8_BAR;
        PG8_STAGE(PG8_SB(1, 0), cB + kstep, voffB); PG8_STAGE(PG8_SA(1, 0), cA + kstep, voffA); PG8_STAGE(PG8_SB(1, 1), cB + hstep + kstep, voffB);
        PG8_WAIT_V(6); PG8_BAR;
    }
    for (;;) {
        const bool has_next = S.next(ui + 1, nxt);
        const char* nA = has_next ? (const char*)(nxt.side == 0 ? g.A : (nxt.side == 1 ? g.A1 : g.A2)) + (size_t)nxt.pm * tstep : cA; const char* nB = has_next ? (const char*)g.Bt + (size_t)nxt.pb * tstep : cB;
        for (int t = 0; t < nt; t += 2) {
            const bool last = (t == nt - 2);
            const char* a1 = cA + (size_t)(t + 1) * kstep;
            const char* a2 = last ? nA : cA + (size_t)(t + 2) * kstep; const char* b2 = last ? nB : cB + (size_t)(t + 2) * kstep;
            const char* a3 = a2 + kstep; const char* b3 = b2 + kstep;
            if (last && has_next) S.a_ready(nxt);
            if constexpr (SP2) {
            PG8_LDB(B0, 0, 0); PG8_LDB(B1, 0, 1); PG8_SCHED; PG8_LDA(At, 0, 0); PG8_STAGE(PG8_SA(1, 1), a1 + hstep, voffA);
            PG8_WAIT_V(8); PG8_WAIT_L(0); PG8_BAR; PG8_MMA(0, 0, At, B0); PG8_MMA(0, 1, At, B1); PG8_BAR; PG8_SCHED;
            PG8_LDA(At, 0, 1); PG8_STAGE(PG8_SB(0, 0), b2, voffB); PG8_STAGE(PG8_SB(0, 1), b2 + hstep, voffB); PG8_STAGE(PG8_SA(0, 0), a2, voffA);
            PG8_WAIT_V(8); PG8_WAIT_L(0); PG8_BAR; PG8_MMA(1, 0, At, B0); PG8_MMA(1, 1, At, B1); PG8_BAR; PG8_SCHED;
            PG8_LDB(B0, 1, 0); PG8_LDB(B1, 1, 1); PG8_SCHED; PG8_LDA(At, 1, 0); PG8_STAGE(PG8_SA(0, 1), a2 + hstep, voffA);
            PG8_WAIT_V(8); PG8_WAIT_L(0); PG8_BAR; PG8_MMA(0, 0, At, B0); PG8_MMA(0, 1, At, B1); PG8_BAR; PG8_SCHED;
            PG8_LDA(At, 1, 1); PG8_STAGE(PG8_SB(1, 0), b3, voffB); PG8_STAGE(PG8_SB(1, 1), b3 + hstep, voffB); PG8_STAGE(PG8_SA(1, 0), a3, voffA);
            PG8_WAIT_V(8); PG8_WAIT_L(0); PG8_BAR; PG8_MMA(1, 0, At, B0); PG8_MMA(1, 1, At, B1); PG8_BAR; PG8_SCHED;
            } else {
            PG8_LDB(B0, 0, 0); PG8_SCHED; PG8_LDA(At, 0, 0); PG8_STAGE(PG8_SA(1, 1), a1 + hstep, voffA);
            PG8_WAIT_L(8); PG8_BAR; PG8_WAIT_L(0); PG8_MMA(0, 0, At, B0); PG8_BAR; PG8_SCHED;
            PG8_LDB(B1, 0, 1); PG8_STAGE(PG8_SB(0, 0), b2, voffB);
            PG8_BAR; PG8_WAIT_L(0); PG8_MMA(0, 1, At, B1); PG8_BAR;
            PG8_LDA(At, 0, 1); PG8_STAGE(PG8_SA(0, 0), a2, voffA);
            PG8_BAR; PG8_WAIT_L(0); PG8_MMA(1, 0, At, B0); PG8_BAR; PG8_SCHED;
            PG8_STAGE(PG8_SB(0, 1), b2 + hstep, voffB);
            PG8_WAIT_V(6); PG8_BAR; PG8_MMA(1, 1, At, B1); PG8_BAR;
            PG8_LDB(B0, 1, 0); PG8_SCHED; PG8_LDA(At, 1, 0); PG8_STAGE(PG8_SA(0, 1), a2 + hstep, voffA);
            PG8_WAIT_L(8); PG8_BAR; PG8_WAIT_L(0); PG8_MMA(0, 0, At, B0); PG8_BAR; PG8_SCHED;
            PG8_LDB(B1, 1, 1); PG8_STAGE(PG8_SB(1, 0), b3, voffB);
            PG8_BAR; PG8_WAIT_L(0); PG8_MMA(0, 1, At, B1); PG8_BAR;
            PG8_LDA(At, 1, 1); PG8_STAGE(PG8_SA(1, 0), a3, voffA);
            PG8_BAR; PG8_WAIT_L(0); PG8_MMA(1, 0, At, B0); PG8_BAR; PG8_SCHED;
            PG8_STAGE(PG8_SB(1, 1), b3 + hstep, voffB);
            PG8_WAIT_V(6); PG8_BAR; PG8_MMA(1, 1, At, B1); PG8_BAR;
            }
        }
        if constexpr (ALIGN_EPI) { if (wr == 0) PG8_BAR; }
        if constexpr (!Epi::AFTER_DRAIN) { E(acc, cur, wr, wc, fr, fq); S.done(cur); }
        if (!has_next) break;
#pragma unroll
        for (int a = 0; a < 2; ++a)
#pragma unroll
            for (int b = 0; b < 2; ++b)
#pragma unroll
                for (int m = 0; m < 4; ++m)
#pragma unroll
                    for (int n = 0; n < 2; ++n) acc[a][b][m][n] = (f32x4){0.f, 0.f, 0.f, 0.f};
        cur = nxt; cA = nA; cB = nB; ++ui;
        if constexpr (ALIGN_EPI) { if (wr == 1) PG8_BAR; }
    }
    PG8_WAIT_V(0);
    if constexpr (!ALIGN_EPI) { if (wr == 0) PG8_BAR; }
    PG8_BAR;
    if constexpr (Epi::AFTER_DRAIN) { E.fused(acc, cur, wr, wc, fr, fq, lds, wid, lane); S.done(cur); }
#undef PG8_SA
#undef PG8_SB
#undef PG8_STAGE
#undef PG8_LDA
#undef PG8_LDB
#undef PG8_MMA
#undef PG8_WAIT_V
#undef PG8_WAIT_L
#undef PG8_BAR
#undef PG8_SCHED
}
}

#include <hip/hip_bf16.h>
#include <cmath>
namespace attn_body {
using bf16=__hip_bfloat16;
using bf16x8=__attribute__((ext_vector_type(8)))short;
using s16x4=__attribute__((ext_vector_type(4)))short;
using f32x16=__attribute__((ext_vector_type(16)))float;
using u32x4=__attribute__((ext_vector_type(4)))unsigned;
constexpr int BATCH=16,SEQ=2048,D=64,DM=1024;
constexpr int NW=8,QBLK=32,QB=QBLK*NW,KVBLK=64,NQB=SEQ/QB;
constexpr int ATTN_PITCH=DM, ATTN_UNIT_ROWS=QB;
__device__ __forceinline__ int crow(int r,int hi){return (r&3)+8*(r>>2)+4*hi;}
#define SBAR() __builtin_amdgcn_sched_barrier(0)
__device__ __forceinline__ void cmask(f32x16&p0,f32x16&p1,int jb,int qrel,int hi){
  const float NEG=-INFINITY; int kb=64*jb+4*hi;
  #pragma unroll
  for(int r=0;r<16;++r){int kv=kb+(r&3)+8*(r>>2); if(kv>qrel)p0[r]=NEG; if(kv+32>qrel)p1[r]=NEG;}
}

constexpr int NSLOT=3, SLOTB=8192;
constexpr int LDS_K=0, LDS_V=NSLOT*SLOTB, LDS_WS=2*NSLOT*SLOTB, LDS_OST=LDS_WS+NW*64*4, LDS_TAB=LDS_OST+NW*8192, LDS_BYTES=LDS_TAB+1024;
constexpr float C2=0.125f*1.4426950408889634f;
__device__ __forceinline__ void glds16(const void*gsrc,unsigned lds_dst){unsigned keep;
  asm volatile("s_mov_b32 %0, m0\n\ts_mov_b32 m0, %2\n\ts_nop 0\n\tglobal_load_lds_dwordx4 %1, off\n\ts_mov_b32 m0, %0":"=&s"(keep):"v"(gsrc),"s"(lds_dst):"memory");}
__device__ __forceinline__ float max3f(float a,float b,float c){float r;asm("v_max3_f32 %0, %1, %2, %3":"=v"(r):"v"(a),"v"(b),"v"(c));return r;}
__device__ __forceinline__ float max2f(float a,float b){float r;asm("v_max_f32_e32 %0, %1, %2":"=v"(r):"v"(a),"v"(b));return r;}
__device__ __forceinline__ float fadd_s(float a,float b){float r;asm("v_add_f32_e32 %0, %1, %2":"=v"(r):"v"(a),"v"(b));return r;}
__device__ __forceinline__ float fsub_s(float a,float b){float r;asm("v_sub_f32_e32 %0, %1, %2":"=v"(r):"v"(a),"v"(b));return r;}
typedef float f32x2_t __attribute__((ext_vector_type(2))); typedef __bf16 bf16x2_t __attribute__((ext_vector_type(2)));
__device__ __forceinline__ unsigned cvtpk_s(float lo,float hi){f32x2_t v={lo,hi};bf16x2_t b=__builtin_convertvector(v,bf16x2_t);return __builtin_bit_cast(unsigned,b);}
#define WAIT_BAR(N) asm volatile("s_waitcnt vmcnt(" #N ") lgkmcnt(0)\n\ts_barrier":::"memory")

__device__ __forceinline__ void qkt(f32x16&p0,f32x16&p1,const char*Kslot,const bf16x8*qr,int r32,int hi){
  const char*kb=Kslot+hi*1024+r32*16;
  #pragma unroll
  for(int d0=0;d0<4;++d0){
    const bf16x8 b0=*reinterpret_cast<const bf16x8*>(kb+d0*2048);
    const bf16x8 b1=*reinterpret_cast<const bf16x8*>(kb+d0*2048+512);
    {p0=__builtin_amdgcn_mfma_f32_32x32x16_bf16(b0,qr[d0],p0,0,0,0);p1=__builtin_amdgcn_mfma_f32_32x32x16_bf16(b1,qr[d0],p1,0,0,0);}}
}
typedef __attribute__((address_space(3))) const char* lds_cptr;
typedef short v4i16_t __attribute__((ext_vector_type(4)));
__device__ __forceinline__ void kload8(bf16x8*kf,lds_cptr kp){
  kf[0]=*(const __attribute__((address_space(3))) bf16x8*)(kp);      kf[1]=*(const __attribute__((address_space(3))) bf16x8*)(kp+512);
  kf[2]=*(const __attribute__((address_space(3))) bf16x8*)(kp+2048); kf[3]=*(const __attribute__((address_space(3))) bf16x8*)(kp+2560);
  kf[4]=*(const __attribute__((address_space(3))) bf16x8*)(kp+4096); kf[5]=*(const __attribute__((address_space(3))) bf16x8*)(kp+4608);
  kf[6]=*(const __attribute__((address_space(3))) bf16x8*)(kp+6144); kf[7]=*(const __attribute__((address_space(3))) bf16x8*)(kp+6656);
}
__device__ __forceinline__ void kload2(bf16x8*kf,lds_cptr kp,int j){ kf[2*j]=*(const __attribute__((address_space(3))) bf16x8*)(kp+j*2048); kf[2*j+1]=*(const __attribute__((address_space(3))) bf16x8*)(kp+j*2048+512); }
__device__ __forceinline__ s16x4 vtr(lds_cptr p){ return __builtin_bit_cast(s16x4,__builtin_amdgcn_ds_read_tr16_b64_v4i16((__attribute__((address_space(3))) v4i16_t*)p)); }
__device__ __forceinline__ float rowmax(const f32x16&p0,const f32x16&p1){
  float a=max3f(p0[0],p0[1],p1[0]),b=max3f(p0[2],p0[3],p1[1]);a=max3f(a,p1[2],p1[3]);
  #pragma unroll
  for(int r=4;r<16;r+=4){a=max3f(a,p0[r],p0[r+1]);b=max3f(b,p0[r+2],p0[r+3]);a=max3f(a,p1[r],p1[r+1]);b=max3f(b,p1[r+2],p1[r+3]);}
  const float m=max2f(a,b);
  auto rr=__builtin_amdgcn_permlane32_swap(__float_as_uint(m),__float_as_uint(m),false,false);
  return max2f(__uint_as_float(rr[0]),__uint_as_float(rr[1]));
}
__device__ __forceinline__ void pv(f32x16*o,int vb,bf16x8 pa0,bf16x8 pa1,bf16x8 pa2,bf16x8 pa3){
  #pragma unroll
  for(int d0=0;d0<2;++d0){s16x4 lo[4],hi[4];
    #pragma unroll
    for(int ks=0;ks<4;++ks){
      asm volatile("ds_read_b64_tr_b16 %0,%1 offset:%c2":"=&v"(lo[ks]):"v"(vb),"i"(d0*4096+ks*1024):"memory");
      asm volatile("ds_read_b64_tr_b16 %0,%1 offset:%c2":"=&v"(hi[ks]):"v"(vb),"i"(d0*4096+ks*1024+512):"memory");}
    asm volatile("s_waitcnt lgkmcnt(0)":::"memory");SBAR();
    #define PK(k) (bf16x8){lo[k][0],lo[k][1],lo[k][2],lo[k][3],hi[k][0],hi[k][1],hi[k][2],hi[k][3]}
    o[d0]=__builtin_amdgcn_mfma_f32_32x32x16_bf16(pa0,PK(0),o[d0],0,0,0);
    o[d0]=__builtin_amdgcn_mfma_f32_32x32x16_bf16(pa1,PK(1),o[d0],0,0,0);
    o[d0]=__builtin_amdgcn_mfma_f32_32x32x16_bf16(pa2,PK(2),o[d0],0,0,0);
    o[d0]=__builtin_amdgcn_mfma_f32_32x32x16_bf16(pa3,PK(3),o[d0],0,0,0);
    #undef PK
  }
}

#ifndef ATTN_STORE16
#define ATTN_STORE16(p,v) (*(u32x4*)(p)=(v))
#endif
template<int THRL> __device__ __forceinline__ void attn_pass(int b,int h,int qb,int p,int vh,const bf16*Q,const bf16*K,const bf16*V,const bf16*SZ,bf16*Y,float*spill,float lam,const float*subln_w,char*shm){
  int tid=threadIdx.x; asm volatile("":"+v"(tid));
  const int lane=tid&63,r32=lane&31,hi=lane>>5; const int wid=__builtin_amdgcn_readfirstlane(tid>>6);
  const long rowbase=(long)b*SEQ; const int q0=qb*QB;
  const bf16*Qw=Q+(rowbase+q0+wid*QBLK)*DM+h*128+p*64;
  const bf16*Kh=K+rowbase*DM+h*128+p*64,*Vh=V+rowbase*DM+h*128+vh*64;
  const int cw=4*qb+(wid>>1), qmin=q0+wid*QBLK; const float*tabf=(const float*)(shm+LDS_TAB);
  const unsigned lds0=(unsigned)(uintptr_t)shm;
  float*wsf=(float*)(shm+LDS_WS)+wid*64;
  const bf16*ksrc=Kh+(long)lane*DM+wid*8;
  const bf16*vsrc=Vh+(long)(16*(wid&3)+(lane>>2))*DM+(wid>>2)*32+(lane&3)*8;
  const unsigned kdst=lds0+LDS_K+wid*1024, vdst=lds0+LDS_V+wid*1024;
  #define DMA_K(t,slot) glds16(ksrc+(long)(t)*KVBLK*DM,(unsigned)__builtin_amdgcn_readfirstlane(kdst+(slot)))
  #define DMA_V(t,slot) glds16(vsrc+(long)(t)*KVBLK*DM,(unsigned)__builtin_amdgcn_readfirstlane(vdst+(slot)))
  const int vb0=(int)(lds0+LDS_V)+((lane>>4)&1)*32+(lane&3)*8+(4*hi+((lane&15)>>2))*64;
  const char*Kbase=shm+LDS_K; bf16x8 kf[8];
  const lds_cptr shm3=(lds_cptr)shm; const lds_cptr kp0=shm3+LDS_K+hi*1024+r32*16; const lds_cptr vp0=shm3+LDS_V+((lane>>4)&1)*32+(lane&3)*8+(4*hi+((lane&15)>>2))*64;
  const int NT=(q0+QB)/KVBLK;
  DMA_K(0,0);DMA_V(0,0);DMA_K(1,SLOTB);
  bf16x8 qr[4];
  #pragma unroll
  for(int d0=0;d0<4;++d0)qr[d0]=*reinterpret_cast<const bf16x8*>(&Qw[(long)r32*DM+d0*16+hi*8]);
  float mhat=0.f,l_reg=0.f;f32x16 o[2];o[0]=f32x16{};o[1]=f32x16{};f32x16 negm; { float z_=0.f; asm volatile("":"+v"(z_)); _Pragma("unroll") for(int r=0;r<16;++r)negm[r]=z_; } asm volatile("":"+v"(negm));
  const int qrel=wid*QBLK+r32;
  #define CMASK(P0,P1,t) do{ if((t)>cw){ _Pragma("unroll") for(int r=0;r<16;++r){P0[r]=-INFINITY;P1[r]=-INFINITY;} } }while(0)
  #define BIASINIT(C0,C1,t) do{ const int base_=64*(t)-qmin; \
    if((t)<=cw && base_+63>=-90){ const float*tb_=tabf+(base_-r32+192+4*hi); \
      _Pragma("unroll") for(int r=0;r<16;++r){ const int o_=(r&3)+8*(r>>2); C0[r]=negm[r]+tb_[o_]; C1[r]=negm[r]+tb_[o_+32]; } } \
    else { _Pragma("unroll") for(int r=0;r<16;++r){ C0[r]=negm[r]; C1[r]=negm[r]; } } }while(0)
  bool resc=false;
  #define START(P0,P1) do{ const float rm=rowmax(P0,P1); resc=false; \
    { const float dl=rm; mhat=fadd_s(mhat,dl); \
      _Pragma("unroll") for(int r=0;r<16;++r){P0[r]=fsub_s(P0[r],dl);P1[r]=fsub_s(P1[r],dl);} \
      _Pragma("unroll") for(int r=0;r<16;++r)negm[r]=-mhat; asm volatile("":"+v"(negm)); } \
    _Pragma("unroll") for(int r=0;r<16;++r)P0[r]=__builtin_amdgcn_exp2f(P0[r]); }while(0)
  #define RESC() do{ if(resc){ asm volatile("s_waitcnt lgkmcnt(0)":::"memory"); \
      _Pragma("unroll") for(int d_=0;d_<2;++d_) _Pragma("unroll") for(int r=0;r<16;++r)o[d_][r]*=wsf[crow(r,hi)]; } }while(0)
  f32x16 pA0,pA1,pB0,pB1;
  int sl_prev=0,sl_cur=0,sl_next=SLOTB;
  #define ROT() do{sl_prev=sl_cur;sl_cur=sl_next;sl_next=(sl_next==(NSLOT-1)*SLOTB)?0:sl_next+SLOTB;}while(0)
  DMA_K(2,2*SLOTB);
  WAIT_BAR(3);
  BIASINIT(pA0,pA1,0); qkt(pA0,pA1,Kbase,qr,r32,hi);asm volatile("s_nop 15\n\ts_nop 7":"+v"(pA0),"+v"(pA1));CMASK(pA0,pA1,0);
  START(pA0,pA1);
  _Pragma("unroll") for(int r=0;r<16;++r)pA1[r]=__builtin_amdgcn_exp2f(pA1[r]);
  WAIT_BAR(0);
  DMA_K(3,0);DMA_V(1,SLOTB);
  ROT();
  kload8(kf,kp0+sl_cur);
  WAIT_BAR(2);
  s16x4 vlo[8],vhi[8]; u32x4 pw0,pw1,pw2,pw3;
  #define PKW(P,B) cvtpk_s(P[B],P[B+1])
  #define PAF(k) __builtin_bit_cast(bf16x8,pw##k)
  #define VFR(i) (bf16x8){vlo[i][0],vlo[i][1],vlo[i][2],vlo[i][3],vhi[i][0],vhi[i][1],vhi[i][2],vhi[i][3]}
  #define PIN(x) asm volatile("":"+v"(x))
  #define MX3(a,b,c) __builtin_fmaxf(__builtin_fmaxf((a),(b)),(c))
  #define GAPA(MF,A0,A1,A2,A3,W0,W1,PW) do{ MF; sacc+=A0; sacc+=A1; sacc+=A2; sacc+=A3; PIN(sacc); W0; W1; PIN(PW); SBAR(); }while(0)
  #define EX(v) __builtin_amdgcn_exp2f(v)
  #define GAPB(MF,X,B) do{ MF; X[B]=EX(X[B]); X[B+1]=EX(X[B+1]); X[B+2]=EX(X[B+2]); X[B+3]=EX(X[B+3]); PIN(X); SBAR(); }while(0)
  #define VRD(i) do{ vlo[i]=vtr(vp_+(((i)>>2)*4096+((i)&3)*1024)); vhi[i]=vtr(vp_+(((i)>>2)*4096+((i)&3)*1024+512)); }while(0)
  #define KRD(G,j) do{ if(G){ kload2(kf,kp0+sl_next,j); SBAR(); } }while(0)
  #define STEP(C0,C1,P0,P1,t,GK,GV,GL,CI0,CI1) do{ SBAR(); \
    const lds_cptr vp_=vp0+sl_prev; \
    VRD(0); SBAR(); float sacc=(P0[0]+P0[1]); \
    GAPA(C0=__builtin_amdgcn_mfma_f32_32x32x16_bf16(kf[0],qr[0],CI0,0,0,0), P0[2],P0[3],P0[4],P0[5],     pw0[0]=PKW(P0,0), pw0[1]=PKW(P0,2), pw0); \
    VRD(4); SBAR(); GAPA(C1=__builtin_amdgcn_mfma_f32_32x32x16_bf16(kf[1],qr[0],CI1,0,0,0), P0[6],P0[7],P0[8],P0[9],     pw0[2]=PKW(P0,4), pw0[3]=PKW(P0,6), pw0); \
    VRD(1); SBAR(); GAPA(C0=__builtin_amdgcn_mfma_f32_32x32x16_bf16(kf[2],qr[1],C0,0,0,0),   P0[10],P0[11],P0[12],P0[13], pw1[0]=PKW(P0,8), pw1[1]=PKW(P0,10), pw1); \
    VRD(5); SBAR(); GAPA(C1=__builtin_amdgcn_mfma_f32_32x32x16_bf16(kf[3],qr[1],C1,0,0,0),   P0[14],P0[15],P1[0],P1[1],   pw1[2]=PKW(P0,12),pw1[3]=PKW(P0,14), pw1); \
    VRD(2); SBAR(); GAPA(C0=__builtin_amdgcn_mfma_f32_32x32x16_bf16(kf[4],qr[2],C0,0,0,0),   P1[2],P1[3],P1[4],P1[5],     pw2[0]=PKW(P1,0), pw2[1]=PKW(P1,2), pw2); \
    VRD(6); SBAR(); GAPA(C1=__builtin_amdgcn_mfma_f32_32x32x16_bf16(kf[5],qr[2],C1,0,0,0),   P1[6],P1[7],P1[8],P1[9],     pw2[2]=PKW(P1,4), pw2[3]=PKW(P1,6), pw2); \
    VRD(3); SBAR(); GAPA(C0=__builtin_amdgcn_mfma_f32_32x32x16_bf16(kf[6],qr[3],C0,0,0,0),   P1[10],P1[11],P1[12],P1[13], pw3[0]=PKW(P1,8), pw3[1]=PKW(P1,10), pw3); \
    VRD(7); SBAR(); GAPA(C1=__builtin_amdgcn_mfma_f32_32x32x16_bf16(kf[7],qr[3],C1,0,0,0),   P1[14],P1[15],0.f,0.f,       pw3[2]=PKW(P1,12),pw3[3]=PKW(P1,14), pw3); \
    l_reg+=sacc; \
    if(GK){DMA_K((t)+3,sl_cur);} if(GV){DMA_V((t)+1,sl_next);} \
    CMASK(C0,C1,t); \
    { float a=MX3(C0[0],C0[1],C1[0]),b=MX3(C0[2],C0[3],C1[1]); a=MX3(a,C1[2],C1[3]); \
      _Pragma("unroll") for(int r=4;r<16;r+=4){a=MX3(a,C0[r],C0[r+1]);b=MX3(b,C0[r+2],C0[r+3]);a=MX3(a,C1[r],C1[r+1]);b=MX3(b,C1[r+2],C1[r+3]);} \
      float rm=__builtin_fmaxf(a,b); { auto rr=__builtin_amdgcn_permlane32_swap(__float_as_uint(rm),__float_as_uint(rm),false,false); rm=__builtin_fmaxf(__uint_as_float(rr[0]),__uint_as_float(rr[1])); } \
      resc=false; \
      if(__builtin_expect(__any(rm>(float)THRL),0)){ const float dl=__builtin_fmaxf(rm,0.f); mhat+=dl; \
        _Pragma("unroll") for(int r=0;r<16;++r){C0[r]-=dl;C1[r]-=dl;} \
        _Pragma("unroll") for(int r=0;r<16;++r)negm[r]=-mhat; asm volatile("":"+v"(negm)); \
        const float f=__builtin_amdgcn_exp2f(-dl); l_reg*=f; if(hi==0)wsf[r32]=f; resc=true; } } \
    SBAR(); \
    GAPB(o[0]=__builtin_amdgcn_mfma_f32_32x32x16_bf16(PAF(0),VFR(0),o[0],0,0,0), C0,0); \
    GAPB(o[1]=__builtin_amdgcn_mfma_f32_32x32x16_bf16(PAF(0),VFR(4),o[1],0,0,0), C0,4); \
    KRD(GL,0); GAPB(o[0]=__builtin_amdgcn_mfma_f32_32x32x16_bf16(PAF(1),VFR(1),o[0],0,0,0), C0,8); \
    KRD(GL,1); GAPB(o[1]=__builtin_amdgcn_mfma_f32_32x32x16_bf16(PAF(1),VFR(5),o[1],0,0,0), C0,12); \
    KRD(GL,2); GAPB(o[0]=__builtin_amdgcn_mfma_f32_32x32x16_bf16(PAF(2),VFR(2),o[0],0,0,0), C1,0); \
    KRD(GL,3); GAPB(o[1]=__builtin_amdgcn_mfma_f32_32x32x16_bf16(PAF(2),VFR(6),o[1],0,0,0), C1,4); \
    GAPB(o[0]=__builtin_amdgcn_mfma_f32_32x32x16_bf16(PAF(3),VFR(3),o[0],0,0,0), C1,8); \
    GAPB(o[1]=__builtin_amdgcn_mfma_f32_32x32x16_bf16(PAF(3),VFR(7),o[1],0,0,0), C1,12); \
    }while(0)
  int t=1;
  #undef CMASK
  #define CMASK(P0,P1,t) do{}while(0)
  for(;t+7<NT;t+=2){
    STEP(pB0,pB1,pA0,pA1,t,true,true,true,negm,negm);     WAIT_BAR(2); RESC(); ROT();
    STEP(pA0,pA1,pB0,pB1,t+1,true,true,true,negm,negm);   WAIT_BAR(2); RESC(); ROT();
  }
  #undef CMASK
  #define CMASK(P0,P1,t) do{ if((t)>cw){ _Pragma("unroll") for(int r=0;r<16;++r){P0[r]=-INFINITY;P1[r]=-INFINITY;} } }while(0)
  #define ENDW(tt) do{ if((tt)+3<NT){WAIT_BAR(2);} else if((tt)+2<NT){WAIT_BAR(1);} else {WAIT_BAR(0);} }while(0)
  for(;t+1<NT;t+=2){
    BIASINIT(pB0,pB1,t);   STEP(pB0,pB1,pA0,pA1,t,(t+3<NT),(t+1<NT),(t+1<NT),pB0,pB1);       ENDW(t);   RESC(); ROT();
    BIASINIT(pA0,pA1,t+1); STEP(pA0,pA1,pB0,pB1,t+1,(t+4<NT),(t+2<NT),(t+2<NT),pA0,pA1);     ENDW(t+1); RESC(); ROT();
  }
  BIASINIT(pB0,pB1,NT-1); STEP(pB0,pB1,pA0,pA1,NT-1,false,false,false,pB0,pB1); RESC();
  { float sacc=pB0[0]+pB0[1]; _Pragma("unroll") for(int r=2;r<16;++r)sacc+=pB0[r]; _Pragma("unroll") for(int r=0;r<16;++r)sacc+=pB1[r]; l_reg+=sacc;
    pw0=(u32x4){PKW(pB0,0),PKW(pB0,2),PKW(pB0,4),PKW(pB0,6)};pw1=(u32x4){PKW(pB0,8),PKW(pB0,10),PKW(pB0,12),PKW(pB0,14)};pw2=(u32x4){PKW(pB1,0),PKW(pB1,2),PKW(pB1,4),PKW(pB1,6)};pw3=(u32x4){PKW(pB1,8),PKW(pB1,10),PKW(pB1,12),PKW(pB1,14)};
    SBAR(); pv(o,vb0+sl_cur,PAF(0),PAF(1),PAF(2),PAF(3)); }
  #undef PKW
  #undef PAF
  #undef VFR
  #undef PIN
  #undef MX3
  #undef GAPA
  #undef GAPB
  #undef EX
  #undef VRD
  #undef KRD
  #undef STEP
  #undef ENDW
  {auto rr=__builtin_amdgcn_permlane32_swap(__float_as_uint(l_reg),__float_as_uint(l_reg),false,false);l_reg=__uint_as_float(rr[0])+__uint_as_float(rr[1]);}
  if(hi==0)wsf[32+r32]=l_reg;asm volatile("s_waitcnt lgkmcnt(0)":::"memory");
  int tid2=threadIdx.x; asm volatile("":"+v"(tid2)); const int lane2=tid2&63,r32b=lane2&31,hib=lane2>>5;
  float*sp=spill+((size_t)blockIdx.x*NW+wid)*2048+lane2;
  unsigned short*stg=(unsigned short*)(shm+LDS_OST)+wid*4096;
  if(p==0){
    #pragma unroll
    for(int r=0;r<16;++r){const float rl=__builtin_amdgcn_rcpf(wsf[32+crow(r,hib)]); sp[r*64]=o[0][r]*rl; sp[(16+r)*64]=o[1][r]*rl;}
  } else {
    #pragma unroll
    for(int r=0;r<16;++r){const float rl=__builtin_amdgcn_rcpf(wsf[32+crow(r,hib)]); const int orow=crow(r,hib);
      const float a0=sp[r*64]-lam*(o[0][r]*rl), a1=sp[(16+r)*64]-lam*(o[1][r]*rl);
      stg[orow*128+vh*64+r32b]=(unsigned short)(cvtpk_s(a0,0.f)&0xffffu); stg[orow*128+vh*64+32+r32b]=(unsigned short)(cvtpk_s(a1,0.f)&0xffffu);}
    if(vh==1){
      asm volatile("s_waitcnt lgkmcnt(0)":::"memory");
      const int row=lane2>>1,half=lane2&1; const unsigned short*srow=stg+row*128+half*64;
      u32x4 w[8]; float ss=0.f;
      #pragma unroll
      for(int i=0;i<8;++i){ w[i]=*(const u32x4*)(srow+i*8);
        #pragma unroll
        for(int e=0;e<4;++e){const float lo=__uint_as_float(w[i][e]<<16),hi2=__uint_as_float(w[i][e]&0xffff0000u); ss+=lo*lo+hi2*hi2;} }
      ss+=__shfl_xor(ss,1);
      const float rs=0.8f/sqrtf(ss*(1.0f/128.0f)+1e-5f);
      const size_t goff=(size_t)(rowbase+q0+wid*QBLK+row)*DM+h*128+half*64;
      #pragma unroll
      for(int i=0;i<8;++i){ const u32x4 z=*(const u32x4*)(SZ+goff+i*8); const float*swp=subln_w+half*64+i*8; u32x4 ov;
        #pragma unroll
        for(int e=0;e<4;++e){ const float a=__uint_as_float(w[i][e]<<16)*rs*swp[2*e]*__uint_as_float(z[e]<<16), c=__uint_as_float(w[i][e]&0xffff0000u)*rs*swp[2*e+1]*__uint_as_float(z[e]&0xffff0000u); ov[e]=cvtpk_s(a,c); }
        *(u32x4*)(Y+goff+i*8)=ov; }
    }
  }
  asm volatile("s_waitcnt lgkmcnt(0)\n\ts_barrier":::"memory");
  #undef DMA_K
  #undef DMA_V
  #undef CMASK
  #undef BIASINIT
  #undef START
  #undef RESC
  #undef ROT
}
constexpr int ATTN_LDS_BYTES=LDS_BYTES;
struct AttnTensors { const bf16* Q; const bf16* K; const bf16* V; const bf16* SZ; bf16* Y; float* spill; const float* tab; const float* subln_w; };
template<int THRL=8> __device__ __forceinline__ void attn_phase(char*lds,const AttnTensors&T,int vcu,int G){
  const int tid=threadIdx.x; float*tabf=(float*)(lds+LDS_TAB);
  const int nun=(G==256)?4:(1024-vcu+G-1)/G;
  for(int i=0;i<nun;++i){
    int bh,qb;
    if(G==256){ bh=vcu>>1; const int s=vcu&1; qb=(i==0)?s:(i==1)?3-s:(i==2)?4+s:7-s; }
    else { const int u=vcu+i*G; bh=u>>3; qb=u&7; }
    const int b=bh>>3,h=bh&7;
    if(tid<256)tabf[tid]=T.tab[h*256+tid];
    const float lam=T.tab[2048];
    for(int ps=0;ps<4;++ps) attn_pass<THRL>(b,h,qb,ps&1,ps>>1,(const bf16*)T.Q,(const bf16*)T.K,(const bf16*)T.V,T.SZ,T.Y,T.spill,lam,T.subln_w,lds);
  }
}
#undef SBAR
#undef WAIT_BAR
}

namespace mlstm_body {
#define ML_LAS __attribute__((address_space(3)))
typedef unsigned short bf16_t;
typedef short bf16x8 __attribute__((ext_vector_type(8)));
typedef float f32x4 __attribute__((ext_vector_type(4)));
typedef float f32x16 __attribute__((ext_vector_type(16)));
typedef unsigned u32x4 __attribute__((ext_vector_type(4)));
typedef unsigned u32x2 __attribute__((ext_vector_type(2)));
typedef float f32x2_t __attribute__((ext_vector_type(2))); typedef __bf16 bf16x2_t __attribute__((ext_vector_type(2)));
constexpr int PQ = 272, PT = 144;
constexpr int O_Q = 0, O_KW = 17408, O_KWT = 34816, O_VT = 53248, O_S = 71680, O_CDT = 80896, O_HN = 115712, O_CONV = 133120, O_ND = 138240, O_DP = 138752, O_DI = 140800, O_CL = 141312, O_LNP = 141568, O_END = 143616;
constexpr int SEQ = 2048, DM = 1024;
struct Tensors { const bf16_t* MQ; const bf16_t* MK; const bf16_t* MV; const float* G; const float* conv_w; const float* conv_b; const float* mh_w; bf16_t* OZ; };
__device__ __forceinline__ unsigned pk(float lo, float hi) { f32x2_t v = {lo, hi}; bf16x2_t b = __builtin_convertvector(v, bf16x2_t); return __builtin_bit_cast(unsigned, b); }
__device__ __forceinline__ float blo(unsigned w) { return __uint_as_float(w << 16); }
__device__ __forceinline__ float bhi(unsigned w) { return __uint_as_float(w & 0xffff0000u); }
__device__ __forceinline__ float silu(float x) { return x * __builtin_amdgcn_rcpf(1.0f + __builtin_amdgcn_exp2f(-1.4426950408889634f * x)); }

__device__ __forceinline__ void mlstm_seq(ML_LAS unsigned char* lds, const Tensors& T, int bh) {
    const int tid = threadIdx.x, lane = tid & 63, wid = __builtin_amdgcn_readfirstlane(tid >> 6), r32 = lane & 31, hi = lane >> 5;
    const int b = bh >> 3, h = bh & 7; const size_t row0 = (size_t)b * SEQ;
    ML_LAS float* CONV = (ML_LAS float*)(lds + O_CONV); ML_LAS float* ND = (ML_LAS float*)(lds + O_ND); ML_LAS float* DP = (ML_LAS float*)(lds + O_DP);
    ML_LAS float* DI = (ML_LAS float*)(lds + O_DI); ML_LAS float* CL = (ML_LAS float*)(lds + O_CL); ML_LAS float* LNP = (ML_LAS float*)(lds + O_LNP);
    for (int i = tid; i < 1280; i += 512) { const int ten = i / 640, j = (i % 640) >> 7, d = i & 127;
        CONV[i] = (j < 4) ? T.conv_w[(ten * 4 + j) * 1024 + h * 128 + d] : T.conv_b[ten * 1024 + h * 128 + d]; }
    const int dch = tid & 15, rg = tid >> 4;
    float mhw[8];
#pragma unroll
    for (int e = 0; e < 8; ++e) mhw[e] = T.mh_w[h * 128 + 8 * dch + e];
    f32x16 C0, C1;
#pragma unroll
    for (int r = 0; r < 16; ++r) { C0[r] = 0.f; C1[r] = 0.f; }
    float nst = 0.f, m_state = 0.f;
    __syncthreads();
    for (int c = 0; c < SEQ / 64; ++c) {
        const int t0 = 64 * c;
        const float ig = T.G[(row0 + t0 + lane) * 16 + h], lf = T.G[(row0 + t0 + lane) * 16 + 8 + h];
        float bcs = lf;
#pragma unroll
        for (int o = 1; o < 64; o <<= 1) { const float t = __shfl_up(bcs, o); if (lane >= o) bcs += t; }
        const float a = ig - bcs; float Mx = a;
#pragma unroll
        for (int o = 1; o < 64; o <<= 1) { const float t = __shfl_up(Mx, o); if (lane >= o) Mx = fmaxf(Mx, t); }
        const float mu63 = fmaxf(m_state, __shfl(Mx, 63)), blast = __shfl(bcs, 63);
        const float wsl = __expf(a - mu63), decay = __expf(m_state - mu63);
        if (wid == 0) CL[lane] = __expf(-bcs - mu63);
        m_state = blast + mu63;
        const float wsA = __shfl(wsl, 2 * rg) * 0.08838834764831845f, wsB = __shfl(wsl, 2 * rg + 1) * 0.08838834764831845f;
        u32x4 ozr[2];
        {
            const size_t gcol = (size_t)h * 128 + 8 * dch;
            u32x4 raw[2][5];
#pragma unroll
            for (int i = 0; i < 5; ++i) { const int tr = t0 + 2 * rg - 3 + i;
                if (tr >= 0) { raw[0][i] = *(const u32x4*)(T.MQ + (row0 + tr) * DM + gcol); raw[1][i] = *(const u32x4*)(T.MK + (row0 + tr) * DM + gcol); }
                else { raw[0][i] = (u32x4){0u, 0u, 0u, 0u}; raw[1][i] = (u32x4){0u, 0u, 0u, 0u}; } }
            u32x4 vr[2];
#pragma unroll
            for (int i = 0; i < 2; ++i) { vr[i] = *(const u32x4*)(T.MV + (row0 + t0 + 2 * rg + i) * DM + gcol); ozr[i] = *(const u32x4*)(T.OZ + (row0 + t0 + 2 * rg + i) * DM + gcol); }
#pragma unroll
            for (int ten = 0; ten < 2; ++ten) {
                float w[5][8];
#pragma unroll
                for (int j = 0; j < 5; ++j) { const f32x4 wa = *(const ML_LAS f32x4*)(CONV + ten * 640 + j * 128 + 8 * dch), wb = *(const ML_LAS f32x4*)(CONV + ten * 640 + j * 128 + 8 * dch + 4);
                    w[j][0] = wa.x; w[j][1] = wa.y; w[j][2] = wa.z; w[j][3] = wa.w; w[j][4] = wb.x; w[j][5] = wb.y; w[j][6] = wb.z; w[j][7] = wb.w; }
                float o0[8], o1[8];
#pragma unroll
                for (int e = 0; e < 8; ++e) { float x[5];
#pragma unroll
                    for (int i = 0; i < 5; ++i) { const unsigned wd = raw[ten][i][e >> 1]; x[i] = (e & 1) ? bhi(wd) : blo(wd); }
                    o0[e] = silu(w[4][e] + w[0][e] * x[0] + w[1][e] * x[1] + w[2][e] * x[2] + w[3][e] * x[3]);
                    o1[e] = silu(w[4][e] + w[0][e] * x[1] + w[1][e] * x[2] + w[2][e] * x[3] + w[3][e] * x[4]); }
                if (ten == 0) {
                    *(ML_LAS u32x4*)(lds + O_Q + (2 * rg) * PQ + 16 * dch) = (u32x4){pk(o0[0], o0[1]), pk(o0[2], o0[3]), pk(o0[4], o0[5]), pk(o0[6], o0[7])};
                    *(ML_LAS u32x4*)(lds + O_Q + (2 * rg + 1) * PQ + 16 * dch) = (u32x4){pk(o1[0], o1[1]), pk(o1[2], o1[3]), pk(o1[4], o1[5]), pk(o1[6], o1[7])};
                } else {
#pragma unroll
                    for (int e = 0; e < 8; ++e) { o0[e] *= wsA; o1[e] *= wsB; }
                    *(ML_LAS u32x4*)(lds + O_KW + (2 * rg) * PQ + 16 * dch) = (u32x4){pk(o0[0], o0[1]), pk(o0[2], o0[3]), pk(o0[4], o0[5]), pk(o0[6], o0[7])};
                    *(ML_LAS u32x4*)(lds + O_KW + (2 * rg + 1) * PQ + 16 * dch) = (u32x4){pk(o1[0], o1[1]), pk(o1[2], o1[3]), pk(o1[4], o1[5]), pk(o1[6], o1[7])};
#pragma unroll
                    for (int e = 0; e < 8; ++e) *(ML_LAS unsigned*)(lds + O_KWT + (8 * dch + e) * PT + 4 * rg) = pk(o0[e], o1[e]);
                }
            }
#pragma unroll
            for (int e = 0; e < 8; ++e) { const unsigned w0 = vr[0][e >> 1], w1 = vr[1][e >> 1];
                *(ML_LAS unsigned*)(lds + O_VT + (8 * dch + e) * PT + 4 * rg) = (e & 1) ? ((w0 >> 16) | (w1 & 0xffff0000u)) : ((w0 & 0xffffu) | (w1 << 16)); }
        }
        {
            const int dj = wid & 3, vb = 64 * (wid >> 2);
#pragma unroll
            for (int r = 0; r < 16; ++r) { C0[r] *= decay; C1[r] *= decay; }
#pragma unroll
            for (int g = 0; g < 4; ++g) { const int d0 = 32 * dj + 8 * g + 4 * hi;
                *(ML_LAS u32x2*)(lds + O_CDT + (vb + r32) * PQ + d0 * 2) = (u32x2){pk(C0[4 * g], C0[4 * g + 1]), pk(C0[4 * g + 2], C0[4 * g + 3])};
                *(ML_LAS u32x2*)(lds + O_CDT + (vb + 32 + r32) * PQ + d0 * 2) = (u32x2){pk(C1[4 * g], C1[4 * g + 1]), pk(C1[4 * g + 2], C1[4 * g + 3])}; }
            if (tid < 128) { nst *= decay; ND[tid] = nst; }
        }
        __syncthreads();
        {
            const int ti = wid >> 1, c16 = lane & 15, q4 = lane >> 4, t = 16 * ti + c16;
            f32x4 acc[2] = {(f32x4){0.f, 0.f, 0.f, 0.f}, (f32x4){0.f, 0.f, 0.f, 0.f}};
#pragma unroll
            for (int kk = 0; kk < 4; ++kk) { const bf16x8 bq = *(const ML_LAS bf16x8*)(lds + O_Q + t * PQ + (32 * kk + 8 * q4) * 2);
#pragma unroll
                for (int j = 0; j < 2; ++j) { const int si = 2 * (wid & 1) + j; const bf16x8 ak = *(const ML_LAS bf16x8*)(lds + O_KW + (16 * si + c16) * PQ + (32 * kk + 8 * q4) * 2);
                    acc[j] = __builtin_amdgcn_mfma_f32_16x16x32_bf16(ak, bq, acc[j], 0, 0, 0); } }
            float dsum = 0.f;
#pragma unroll
            for (int j = 0; j < 2; ++j) { const int s0 = 16 * (2 * (wid & 1) + j) + 4 * q4; float x[4];
#pragma unroll
                for (int e = 0; e < 4; ++e) { x[e] = (s0 + e <= t) ? acc[j][e] : 0.f; dsum += x[e]; }
                *(ML_LAS u32x2*)(lds + O_S + t * PT + s0 * 2) = (u32x2){pk(x[0], x[1]), pk(x[2], x[3])}; }
            dsum += __shfl_xor(dsum, 16); dsum += __shfl_xor(dsum, 32);
            if (q4 == 0) DI[(wid & 1) * 64 + t] = dsum;
            const u32x4 qa = *(const ML_LAS u32x4*)(lds + O_Q + lane * PQ + 32 * wid), qb = *(const ML_LAS u32x4*)(lds + O_Q + lane * PQ + 32 * wid + 16);
            float p = 0.f;
#pragma unroll
            for (int e = 0; e < 4; ++e) { const f32x4 n0 = *(const ML_LAS f32x4*)(ND + 16 * wid + 4 * e); const unsigned w0 = (e < 2) ? qa[2 * e] : qb[2 * e - 4], w1 = (e < 2) ? qa[2 * e + 1] : qb[2 * e - 3];
                p += blo(w0) * n0.x + bhi(w0) * n0.y + blo(w1) * n0.z + bhi(w1) * n0.w; }
            DP[wid * 64 + lane] = p;
        }
        __syncthreads();
        f32x16 acc;
        float mean_s1, mean_s2;
        const int ti = wid & 1, vi = wid >> 1, tl = 32 * ti + r32;
        {
#pragma unroll
            for (int r = 0; r < 16; ++r) acc[r] = 0.f;
#pragma unroll
            for (int ks = 0; ks < 4; ++ks) { const bf16x8 av = *(const ML_LAS bf16x8*)(lds + O_VT + (32 * vi + r32) * PT + (16 * ks + 8 * hi) * 2), bs = *(const ML_LAS bf16x8*)(lds + O_S + tl * PT + (16 * ks + 8 * hi) * 2);
                acc = __builtin_amdgcn_mfma_f32_32x32x16_bf16(av, bs, acc, 0, 0, 0); }
#pragma unroll
            for (int ks = 0; ks < 8; ++ks) { const bf16x8 ac = *(const ML_LAS bf16x8*)(lds + O_CDT + (32 * vi + r32) * PQ + (16 * ks + 8 * hi) * 2), bq = *(const ML_LAS bf16x8*)(lds + O_Q + tl * PQ + (16 * ks + 8 * hi) * 2);
                acc = __builtin_amdgcn_mfma_f32_32x32x16_bf16(ac, bq, acc, 0, 0, 0); }
            const int dj = wid & 3, vb = 64 * (wid >> 2);
#pragma unroll
            for (int ks = 0; ks < 4; ++ks) { const bf16x8 ak = *(const ML_LAS bf16x8*)(lds + O_KWT + (32 * dj + r32) * PT + (16 * ks + 8 * hi) * 2);
                const bf16x8 b0 = *(const ML_LAS bf16x8*)(lds + O_VT + (vb + r32) * PT + (16 * ks + 8 * hi) * 2), b1 = *(const ML_LAS bf16x8*)(lds + O_VT + (vb + 32 + r32) * PT + (16 * ks + 8 * hi) * 2);
                C0 = __builtin_amdgcn_mfma_f32_32x32x16_bf16(ak, b0, C0, 0, 0, 0); C1 = __builtin_amdgcn_mfma_f32_32x32x16_bf16(ak, b1, C1, 0, 0, 0); }
            if (tid < 128) { float sk = 0.f;
#pragma unroll
                for (int i = 0; i < 8; ++i) { const u32x4 kw = *(const ML_LAS u32x4*)(lds + O_KWT + tid * PT + 16 * i);
#pragma unroll
                    for (int e = 0; e < 4; ++e) sk += blo(kw[e]) + bhi(kw[e]); }
                nst += sk; }
            float den = DI[tl] + DI[64 + tl];
#pragma unroll
            for (int sg = 0; sg < 8; ++sg) den += DP[sg * 64 + tl];
            const float rden = 1.0f / fmaxf(fabsf(den), CL[tl]);
            float s1 = 0.f, s2 = 0.f;
#pragma unroll
            for (int r = 0; r < 16; ++r) { acc[r] *= rden; s1 += acc[r]; s2 += acc[r] * acc[r]; }
            s1 += __shfl_xor(s1, 32); s2 += __shfl_xor(s2, 32);
            if (hi == 0) { LNP[(vi * 64 + tl) * 2] = s1; LNP[(vi * 64 + tl) * 2 + 1] = s2; }
        }
        __syncthreads();
        {
            mean_s1 = 0.f; mean_s2 = 0.f;
#pragma unroll
            for (int j = 0; j < 4; ++j) { mean_s1 += LNP[(j * 64 + tl) * 2]; mean_s2 += LNP[(j * 64 + tl) * 2 + 1]; }
            const float mu = mean_s1 * (1.f / 128.f), var = mean_s2 * (1.f / 128.f) - mu * mu, rstd = 1.0f / sqrtf(fmaxf(var, 0.f) + 1e-5f);
#pragma unroll
            for (int g = 0; g < 4; ++g) { const int v0 = 32 * vi + 8 * g + 4 * hi;
                *(ML_LAS u32x2*)(lds + O_HN + tl * PQ + v0 * 2) = (u32x2){pk((acc[4 * g] - mu) * rstd, (acc[4 * g + 1] - mu) * rstd), pk((acc[4 * g + 2] - mu) * rstd, (acc[4 * g + 3] - mu) * rstd)}; }
        }
        __syncthreads();
#pragma unroll
        for (int i = 0; i < 2; ++i) { const u32x4 hn = *(const ML_LAS u32x4*)(lds + O_HN + (2 * rg + i) * PQ + 16 * dch); u32x4 ov;
#pragma unroll
            for (int e = 0; e < 4; ++e) ov[e] = pk(blo(hn[e]) * mhw[2 * e] * blo(ozr[i][e]), bhi(hn[e]) * mhw[2 * e + 1] * bhi(ozr[i][e]));
            *(u32x4*)(T.OZ + (row0 + t0 + 2 * rg + i) * DM + (size_t)h * 128 + 8 * dch) = ov; }
    }
    __syncthreads();
}
}

constexpr int NWAVES = 8;
constexpr int BATCH = 16, SEQ = 2048, DM = 1024, M = BATCH * SEQ, DIN = 11280, NH = 8;
constexpr int N1 = 9216;
constexpr float C2 = 0.125f * 1.4426950408889634f;
constexpr float LOG2E = 1.4426950408889634f;
constexpr float LAMBDA_INIT = 0.2f;
constexpr size_t MiB = 1u << 20;
constexpr size_t WS_CTL = 0, CTL_ZERO_BYTES = 1 * MiB;
constexpr size_t WS_TAB = 1 * MiB;
constexpr size_t WS_G = 2 * MiB;
constexpr size_t WS_W1 = 4 * MiB;
constexpr size_t WS_WG = 22 * MiB;
constexpr size_t WS_WP = 26 * MiB;
constexpr size_t WS_WO = 30 * MiB;
constexpr size_t WS_XN = 32 * MiB;
constexpr size_t WS_BQ = 96 * MiB, BUF = 64 * MiB;
constexpr size_t WS_BK = WS_BQ + BUF, WS_BV = WS_BQ + 2 * BUF, WS_BZ = WS_BQ + 3 * BUF, WS_MQ = WS_BQ + 4 * BUF, WS_MK = WS_BQ + 5 * BUF;
constexpr size_t WS_SP = 480 * MiB;
constexpr size_t WS_END = 512 * MiB;

constexpr int LDS_BYTES = 163840, MISC_OFF = LDS_BYTES - 256;
constexpr int CW_BAR = 4096;

#define GAS __attribute__((address_space(1)))
#define LAS __attribute__((address_space(3)))
typedef unsigned short bf16;
typedef unsigned v4u __attribute__((ext_vector_type(4)));
typedef float f32x4 __attribute__((ext_vector_type(4)));
#define LDS_WAIT() asm volatile("s_waitcnt lgkmcnt(0)" ::: "memory")
#define VM_WAIT() asm volatile("s_waitcnt vmcnt(0)" ::: "memory")
__device__ __forceinline__ unsigned f2bf(float f) { unsigned u = __builtin_bit_cast(unsigned, f); return (u + 0x7fffu + ((u >> 16) & 1u)) >> 16; }
__device__ __forceinline__ unsigned pk2(float lo, float hi) { return f2bf(lo) | (f2bf(hi) << 16); }
__device__ __forceinline__ float bf2f(bf16 v) { return __uint_as_float((unsigned)v << 16); }
__device__ __forceinline__ float wave_sum(float v) {
#pragma unroll
    for (int o = 1; o < 64; o <<= 1) v += __shfl_xor(v, o);
    return v;
}

typedef GAS unsigned gu32;
#define RLX_AGENT __ATOMIC_RELAXED, __HIP_MEMORY_SCOPE_AGENT
#define XB_TMO      128
#define XB_XCNT(j)  (256  + 64 * (j))
#define XB_XSUB(j)  (1280 + 64 * (j))
#define XB_XGEN(j)  (2304 + 64 * (j))
#define XB_TOP      3328
#define XB_TOPGEN   3392
#define XCD_BAR_WORDS 3456
#define XB_SPIN_CAP (1u << 18)

__device__ __forceinline__ unsigned xb_ld(unsigned* p)              { return __hip_atomic_load(p, __ATOMIC_RELAXED, __HIP_MEMORY_SCOPE_AGENT); }
__device__ __forceinline__ unsigned xb_add(unsigned* p, unsigned v) { return __hip_atomic_fetch_add(p, v, __ATOMIC_RELAXED, __HIP_MEMORY_SCOPE_AGENT); }
__device__ __forceinline__ unsigned xb_xcc_id() { return (unsigned)__builtin_amdgcn_s_getreg((3 << 11) | 20) & 0xFu; }
#define XB_SPIN(cond, bar) do { unsigned _sp = 0; while (cond) { __builtin_amdgcn_s_sleep(1); \
    if ((++_sp & 255u) == 0u) { if (xb_ld(&(bar)[XB_TMO])) break; if (_sp > XB_SPIN_CAP) { atomicAdd(&(bar)[XB_TMO], 1u); break; } } } } while (0)

struct XcdBarrier {
    unsigned* bar; unsigned x;
    volatile LAS unsigned* st;
};

__device__ __forceinline__ XcdBarrier xcd_barrier_post(unsigned* bar, volatile LAS unsigned* st) {
    XcdBarrier b; b.bar = bar; b.x = xb_xcc_id(); b.st = st;
    if (threadIdx.x == 0) (void)xb_add(&bar[XB_XCNT(b.x)], 1u);
    return b;
}
__device__ __forceinline__ void xcd_barrier_complete(unsigned* bar, unsigned x, unsigned& nloc, unsigned& nx) {
    const unsigned G = gridDim.x * gridDim.y * gridDim.z;
    unsigned sum, cnt, mine, sp = 0u;
    for (;;) {
        sum = 0u; cnt = 0u; mine = 0u;
#pragma unroll
        for (unsigned j = 0; j < 16; ++j) { const unsigned c = xb_ld(&bar[XB_XCNT(j)]); sum += c; cnt += (c > 0u) ? 1u : 0u; mine = (j == x) ? c : mine; }
        if (sum == G) break;
        __builtin_amdgcn_s_sleep(1);
        if ((++sp & 255u) == 0u) { if (xb_ld(&bar[XB_TMO])) break; if (sp > XB_SPIN_CAP) { atomicAdd(&bar[XB_TMO], 1u); break; } }
    }
    nloc = mine > 0u ? mine : 1u; nx = cnt > 0u ? cnt : 1u;
}

__device__ __forceinline__ void xcd_barrier(const XcdBarrier& b) {
    asm volatile("s_waitcnt vmcnt(0)" ::: "memory");
    __syncthreads();
    if (threadIdx.x == 0) {
        unsigned* bar = b.bar;
        __builtin_amdgcn_s_waitcnt(0);
        unsigned nloc = b.st[0], nx = b.st[1];
        if (nloc == 0u) { xcd_barrier_complete(bar, b.x, nloc, nx); b.st[0] = nloc; b.st[1] = nx; }
        const unsigned old = xb_add(&bar[XB_XSUB(b.x)], 1u);
        const unsigned gen = old / nloc;
        if (old + 1u == (gen + 1u) * nloc) {
            __builtin_amdgcn_fence(__ATOMIC_RELEASE, "agent");
            asm volatile("s_waitcnt vmcnt(0)" ::: "memory");
            const unsigned og = xb_add(&bar[XB_TOP], 1u);
            const unsigned tg = og / nx;
            if (og + 1u == (tg + 1u) * nx) xb_add(&bar[XB_TOPGEN], 1u);
            else XB_SPIN(xb_ld(&bar[XB_TOPGEN]) == tg, bar);
            __builtin_amdgcn_fence(__ATOMIC_ACQUIRE, "agent");
            xb_add(&bar[XB_XGEN(b.x)], 1u);
            asm volatile("s_waitcnt vmcnt(0)" ::: "memory");
        } else {
            XB_SPIN(xb_ld(&bar[XB_XGEN(b.x)]) == gen, bar);
            __builtin_amdgcn_fence(__ATOMIC_ACQUIRE, "agent");
            asm volatile("s_waitcnt vmcnt(0)" ::: "memory");
        }
    }
    __syncthreads();
}


struct Frame {
    LAS unsigned char* lds;
    int tid, lane, wave, vcu, G;
    const float *x, *norm_w, *w_in, *lam, *subln_w, *rel_bias, *conv_w, *conv_b, *b_if, *mh_w, *b_gate, *w_pa, *w_pm, *w_out, *norm_final;
    float* out; unsigned char* ws;
};

__device__ __forceinline__ void tr_item(const float* W, int ldw, int src_n0, bf16* WT, int K, int dst_n0, int k0, LAS float* scr, int lane) {
#pragma unroll 8
    for (int i = 0; i < 32; ++i) { const int kk = 2 * i + (lane >> 5); scr[kk * 33 + (lane & 31)] = W[(size_t)(k0 + kk) * ldw + src_n0 + (lane & 31)]; }
    LDS_WAIT(); asm volatile("" ::: "memory");
    const int c = lane & 7;
#pragma unroll
    for (int j = 0; j < 4; ++j) { const int n = (lane >> 3) + 8 * j; const LAS float* s = scr + (8 * c) * 33 + n;
        v4u o; o.x = pk2(s[0 * 33], s[1 * 33]); o.y = pk2(s[2 * 33], s[3 * 33]); o.z = pk2(s[4 * 33], s[5 * 33]); o.w = pk2(s[6 * 33], s[7 * 33]);
        *(GAS v4u*)(WT + (size_t)(dst_n0 + n) * K + k0 + 8 * c) = o; }
    LDS_WAIT(); asm volatile("" ::: "memory");
}
__device__ __forceinline__ int w1_src_col(int n0) {
    if (n0 < 7168) return n0;
    const int t = (n0 - 7168) >> 8, w = (n0 - 7168) & 255;
    return (w < 128) ? 7168 + t * 128 + w : 8192 + t * 128 + (w - 128);
}
__device__ __forceinline__ float log_sigmoid_f(float x) { return fminf(x, 0.f) - log1pf(expf(-fabsf(x))); }
__device__ __forceinline__ int rel_bucket(int rel) {
    const int n = rel < 0 ? -rel : rel; int b = rel > 0 ? 16 : 0;
    int large = 8 + (n >= 12) + (n >= 16) + (n >= 23) + (n >= 32) + (n >= 46) + (n >= 64) + (n >= 91);
    return b + (n < 8 ? n : large);
}

__device__ __forceinline__ void p0_prologue(Frame& F) {
    const float* wpa = F.w_pa; const float* wpm = F.w_pm; const float* wout = F.w_out;
    asm volatile("" : "+s"(wpa), "+s"(wpm), "+s"(wout));
    const int gw = F.vcu * NWAVES + F.wave, NGW = F.G * NWAVES;
    if (blockIdx.x == 0) {
        float* tab = (float*)(F.ws + WS_TAB);
        for (int i = F.tid; i < 8 * 256; i += NWAVES * 64) { const int h = i >> 8, delta = (i & 255) - 192;
            tab[i] = (F.rel_bias[rel_bucket(delta) * 8 + h] - F.rel_bias[15 * 8 + h]) * LOG2E; }
        if (F.wave == 0) { const float a = wave_sum(F.lam[F.lane] * F.lam[64 + F.lane]), b = wave_sum(F.lam[128 + F.lane] * F.lam[192 + F.lane]);
            if (F.lane == 0) tab[2048] = expf(a) - expf(b) + LAMBDA_INIT; }
    }
    { LAS float* scr = (LAS float*)(F.lds + F.wave * 16384);
      constexpr int I_W1 = 16 * (N1 / 32), I_WG = 16 * (2048 / 32), I_P = 16 * (1024 / 32);
      constexpr int NITEMS = I_W1 + I_WG + 3 * I_P;
      for (int it = gw; it < NITEMS; it += NGW) {
          int r = it; const float* W; int ldw, src, dst, kb; bf16* WT;
          if (r < I_W1) { kb = r / (N1 / 32); const int nb = r % (N1 / 32); W = F.w_in; ldw = DIN; src = w1_src_col(nb * 32); WT = (bf16*)(F.ws + WS_W1); dst = nb * 32; }
          else if ((r -= I_W1) < I_WG) { kb = r / 64; const int nb = r % 64; W = F.w_in; ldw = DIN; src = 9232 + nb * 32; WT = (bf16*)(F.ws + WS_WG); dst = nb * 32; }
          else { r -= I_WG; const int wsel = r / I_P; r -= wsel * I_P; kb = r / 32; const int nb = r % 32; ldw = 1024; src = nb * 32;
                 W = (wsel == 0) ? wpa : (wsel == 1) ? wpm : wout; WT = (bf16*)(F.ws + (wsel == 2 ? WS_WO : WS_WP)); dst = (wsel == 1 ? 1024 : 0) + nb * 32; }
          tr_item(W, ldw, src, WT, 1024, dst, kb * 64, scr, F.lane);
      } }
    __syncthreads();
    LAS float* T = (LAS float*)F.lds;
    for (int i = F.tid; i < 1024 * 4; i += NWAVES * 64) { const int k = i >> 2, q = i & 3; const int p = ((k & 3) + 4 * (k >> 8)) * 64 + ((k >> 2) & 63);
        *(LAS f32x4*)(T + p * 20 + q * 4) = *(const f32x4*)(F.w_in + (size_t)k * DIN + 9216 + q * 4); }
    __syncthreads();
    f32x4 nw[4];
#pragma unroll
    for (int j = 0; j < 4; ++j) nw[j] = *(const f32x4*)(F.norm_w + 4 * F.lane + 256 * j);
    float bi = 0.f; if (F.lane < 16) bi = F.b_if[F.lane];
    bf16* XN = (bf16*)(F.ws + WS_XN); float* Gt = (float*)(F.ws + WS_G);
    for (int m = gw; m < M; m += NGW) {
        const GAS f32x4* xr = (const GAS f32x4*)(F.x + (size_t)m * DM) + F.lane;
        f32x4 v[4]; float ss = 0.f;
#pragma unroll
        for (int j = 0; j < 4; ++j) { v[j] = xr[64 * j]; ss += (v[j].x * v[j].x + v[j].y * v[j].y) + (v[j].z * v[j].z + v[j].w * v[j].w); }
        const float r = 1.0f / sqrtf(wave_sum(ss) * (1.f / DM) + 1e-6f);
        float s[16];
#pragma unroll
        for (int n = 0; n < 16; ++n) s[n] = 0.f;
        GAS unsigned long long* o8 = (GAS unsigned long long*)(XN + (size_t)m * DM) + F.lane;
#pragma unroll
        for (int j = 0; j < 4; ++j) { v[j] = v[j] * r * nw[j];
            o8[64 * j] = (unsigned long long)pk2(v[j].x, v[j].y) | ((unsigned long long)pk2(v[j].z, v[j].w) << 32);
#pragma unroll
            for (int i = 0; i < 4; ++i) { const LAS float* tp = T + ((i + 4 * j) * 64 + F.lane) * 20; const float xv = v[j][i];
#pragma unroll
                for (int q = 0; q < 4; ++q) { const f32x4 w = *(const LAS f32x4*)(tp + 4 * q); s[4 * q] += xv * w.x; s[4 * q + 1] += xv * w.y; s[4 * q + 2] += xv * w.z; s[4 * q + 3] += xv * w.w; }
                asm volatile("" ::: "memory"); } }
        float mine = 0.f;
#pragma unroll
        for (int n = 0; n < 16; ++n) { const float t = wave_sum(s[n]); mine = (F.lane == n) ? t : mine; }
        if (F.lane < 16) { const float pre = mine + bi; Gt[(size_t)m * 16 + F.lane] = (F.lane < 8) ? pre : log_sigmoid_f(pre); }
    }
}

__device__ __forceinline__ void p_final_norm(Frame& F) {
    const int gw = F.vcu * NWAVES + F.wave, NGW = F.G * NWAVES;
    f32x4 nw[4];
#pragma unroll
    for (int j = 0; j < 4; ++j) nw[j] = *(const f32x4*)(F.norm_final + 4 * F.lane + 256 * j);
    for (int m = gw; m < M; m += NGW) {
        GAS f32x4* xr = (GAS f32x4*)(F.out + (size_t)m * DM) + F.lane;
        f32x4 v[4]; float ss = 0.f;
#pragma unroll
        for (int j = 0; j < 4; ++j) { v[j] = xr[64 * j]; ss += (v[j].x * v[j].x + v[j].y * v[j].y) + (v[j].z * v[j].z + v[j].w * v[j].w); }
        const float r = 1.0f / sqrtf(wave_sum(ss) * (1.f / DM) + 1e-6f);
#pragma unroll
        for (int j = 0; j < 4; ++j) xr[64 * j] = v[j] * r * nw[j];
    }
}

struct Args { const float* in[15]; float* out; unsigned char* ws; int ph_lo, ph_hi; };
__global__ void __launch_bounds__(NWAVES * 64, 2) skel_fwd(Args args) {
    extern __shared__ __attribute__((aligned(16))) unsigned char lds[];
    Frame F;
    F.lds = (LAS unsigned char*)lds;
    F.tid = threadIdx.x; F.lane = F.tid & 63; F.wave = __builtin_amdgcn_readfirstlane(F.tid >> 6);
    F.G = gridDim.x; { const int bx = blockIdx.x; F.vcu = (F.G % 8 == 0) ? (bx % 8) * (F.G / 8) + bx / 8 : bx; }
    F.x = args.in[0]; F.norm_w = args.in[1]; F.w_in = args.in[2]; F.lam = args.in[3]; F.subln_w = args.in[4]; F.rel_bias = args.in[5]; F.conv_w = args.in[6]; F.conv_b = args.in[7];
    F.b_if = args.in[8]; F.mh_w = args.in[9]; F.b_gate = args.in[10]; F.w_pa = args.in[11]; F.w_pm = args.in[12]; F.w_out = args.in[13]; F.norm_final = args.in[14];
    F.out = args.out; F.ws = args.ws;
    unsigned char* ws = args.ws;
    const int lo = args.ph_lo, hi = args.ph_hi;
#define IN(k) (lo <= (k) && (k) < hi)
    volatile LAS unsigned* MISC = (volatile LAS unsigned*)(F.lds + MISC_OFF);
    if (F.tid < 64) MISC[F.tid] = 0u;
    __syncthreads();
    XcdBarrier bar; bar.bar = (unsigned*)(ws + WS_CTL) + CW_BAR; bar.x = 0; bar.st = nullptr;
    if (hi - lo > 1) bar = xcd_barrier_post((unsigned*)(ws + WS_CTL) + CW_BAR, MISC + 8);
    int n_sync = 0;
#define GRID_SYNC(cond) do { if (cond) { if (USE_CG_SYNC || (CG_FIRST && n_sync == 0)) { cooperative_groups::this_grid().sync(); } else { xcd_barrier(bar); } ++n_sync; } } while (0)
    if (IN(0)) p0_prologue(F);
    GRID_SYNC(IN(0) && IN(1));
    if (IN(1)) {
        pg8::Gemm g{(const bf16*)(ws + WS_XN), nullptr, nullptr, (const bf16*)(ws + WS_W1), M, N1, DM}; pg8::StaticOrder S; S.init(M, N1, F.G, (int)blockIdx.x);
        pg8::EpiP1 E{(bf16*)(ws + WS_BQ), BUF / 2, (bf16*)F.out, (bf16*)F.out + (size_t)M * DM, C2};
        pg8::gemm_phase<pg8::EpiP1, pg8::StaticOrder, true, true>(F.lds, g, S, E);
    }
    GRID_SYNC(IN(1) && IN(2));
    if (IN(2)) {
        const attn_body::AttnTensors AT{(const attn_body::bf16*)(ws + WS_BQ), (const attn_body::bf16*)(ws + WS_BK), (const attn_body::bf16*)(ws + WS_BV), (const attn_body::bf16*)(ws + WS_BZ),
                                        (attn_body::bf16*)(ws + WS_BQ), (float*)(ws + WS_SP), (const float*)(ws + WS_TAB), F.subln_w};
        attn_body::attn_phase<8>((char*)lds, AT, F.vcu, F.G);
    }
    if (IN(3)) {
        if (F.vcu < BATCH * NH) { const mlstm_body::Tensors MT{(const bf16*)(ws + WS_MQ), (const bf16*)(ws + WS_MK), (const bf16*)F.out, (const float*)(ws + WS_G), F.conv_w, F.conv_b, F.mh_w, (bf16*)F.out + (size_t)M * DM};
            for (int bh = F.vcu; bh < BATCH * NH; bh += F.G) mlstm_body::mlstm_seq(F.lds, MT, bh); }
    }
    GRID_SYNC(IN(3) && IN(4));
    if (IN(4)) {
        pg8::Gemm g{(const bf16*)(ws + WS_XN), (const bf16*)(ws + WS_BQ), (const bf16*)F.out + (size_t)M * DM, (const bf16*)(ws + WS_WG), M, DM, DM}; pg8::QuadOrder S; S.init(M, DM, F.G, (int)blockIdx.x);
        pg8::EpiGM E{(bf16*)(ws + WS_BK), (bf16*)(ws + WS_BV), (bf16*)(ws + WS_BZ), (bf16*)(ws + WS_MQ), F.b_gate};
        pg8::gemm_phase<pg8::EpiGM, pg8::QuadOrder, true, true>(F.lds, g, S, E);
    }
    GRID_SYNC(IN(4) && IN(6));
    if (IN(6)) {
        pg8::Gemm g{(const bf16*)(ws + WS_MQ), nullptr, nullptr, (const bf16*)(ws + WS_WO), M, DM, DM}; pg8::StaticOrder S; S.init(M, DM, F.G, (int)blockIdx.x);
        pg8::EpiRes E{F.x, F.out};
        pg8::gemm_phase<pg8::EpiRes, pg8::StaticOrder, true, true>(F.lds, g, S, E);
    }
    GRID_SYNC(IN(6) && IN(7));
    if (IN(7)) p_final_norm(F);
#undef IN
}

__global__ void __launch_bounds__(256) naive_attn(const bf16* Q, const bf16* K, const bf16* V, const bf16* SZ, const float* tab, const float* subln_w, bf16* Y) {
    __shared__ float Ks[64][64]; __shared__ float Vs[64][128]; __shared__ float red[4][64]; __shared__ float tabs[256];
    const int tid = threadIdx.x, qi = tid & 63, vq = tid >> 6;
    const int c = blockIdx.x & 31, bh = blockIdx.x >> 5, b = bh >> 3, h = bh & 7;
    const float lamv = tab[2048];
    tabs[tid] = tab[h * 256 + tid];
    const size_t qrow = (size_t)b * SEQ + 64 * c + qi;
    float o0[32], attn[32];
    for (int p = 0; p < 2; ++p) {
        float q[64];
#pragma unroll
        for (int d = 0; d < 64; ++d) q[d] = bf2f(Q[qrow * DM + h * 128 + p * 64 + d]);
        float mx = -1e30f, l = 0.f, o[32];
#pragma unroll
        for (int i = 0; i < 32; ++i) o[i] = 0.f;
        for (int j = 0; j <= c; ++j) {
            __syncthreads();
            for (int e = tid; e < 64 * 64; e += 256) { const int s = e >> 6, d = e & 63; Ks[s][d] = bf2f(K[((size_t)b * SEQ + 64 * j + s) * DM + h * 128 + p * 64 + d]); }
            for (int e = tid; e < 64 * 128; e += 256) { const int s = e >> 7, d = e & 127; Vs[s][d] = bf2f(V[((size_t)b * SEQ + 64 * j + s) * DM + h * 128 + d]); }
            __syncthreads();
            for (int s = 0; s < 64; ++s) {
                float dot = 0.f;
#pragma unroll
                for (int d = 0; d < 64; ++d) dot += q[d] * Ks[s][d];
                const int idx = (64 * j + s) - (64 * c + qi) + 192;
                const float logit = dot + (idx >= 0 ? tabs[idx] : 0.f);
                const float mn = fmaxf(mx, logit), sc = exp2f(mx - mn), pr = exp2f(logit - mn);
                l = l * sc + pr; mx = mn;
#pragma unroll
                for (int i = 0; i < 32; ++i) o[i] = o[i] * sc + pr * Vs[s][32 * vq + i];
            }
        }
        const float il = 1.0f / l;
#pragma unroll
        for (int i = 0; i < 32; ++i) { if (p == 0) o0[i] = o[i] * il; else attn[i] = o0[i] - lamv * (o[i] * il); }
    }
    float ss = 0.f;
#pragma unroll
    for (int i = 0; i < 32; ++i) ss += attn[i] * attn[i];
    red[vq][qi] = ss; __syncthreads();
    const float r = 1.0f / sqrtf((red[0][qi] + red[1][qi] + red[2][qi] + red[3][qi]) * (1.f / 128.f) + 1e-5f);
#pragma unroll
    for (int i = 0; i < 32; ++i) { const size_t a = qrow * DM + h * 128 + 32 * vq + i;
        Y[a] = (bf16)f2bf(attn[i] * r * subln_w[32 * vq + i] * (1.0f - LAMBDA_INIT) * bf2f(SZ[a])); }
}

__global__ void __launch_bounds__(256) naive_mlstm(const bf16* MQ, const bf16* MK, const bf16* MV, const float* G, const float* conv_w, const float* conv_b, const float* mh_w, bf16* OZ) {
    __shared__ float qs[128], ks[128], vs[128], part[2][128], red[4][4];
    const int tid = threadIdx.x, bh = blockIdx.x, b = bh >> 3, h = bh & 7, ch = tid & 127, isk = tid >> 7, lane = tid & 63, wave = tid >> 6;
    const bf16* src = isk ? MK : MQ;
    const float w0 = conv_w[(isk * 4 + 0) * 1024 + h * 128 + ch], w1 = conv_w[(isk * 4 + 1) * 1024 + h * 128 + ch], w2 = conv_w[(isk * 4 + 2) * 1024 + h * 128 + ch], w3 = conv_w[(isk * 4 + 3) * 1024 + h * 128 + ch];
    const float cb = conv_b[isk * 1024 + h * 128 + ch], mw = mh_w[h * 128 + ch];
    float h1 = 0.f, h2 = 0.f, h3 = 0.f, C[64], nst = 0.f;
#pragma unroll
    for (int j = 0; j < 64; ++j) C[j] = 0.f;
    for (int t = 0; t < SEQ; ++t) {
        const size_t row = (size_t)b * SEQ + t;
        const float raw = bf2f(src[row * DM + h * 128 + ch]);
        float cv = cb + w0 * h3 + w1 * h2 + w2 * h1 + w3 * raw; h3 = h2; h2 = h1; h1 = raw;
        cv = cv / (1.0f + expf(-cv));
        if (isk) ks[ch] = cv * 0.08838834764831845f; else { qs[ch] = cv; vs[ch] = bf2f(MV[row * DM + h * 128 + ch]); }
        __syncthreads();
        const float f = expf(G[row * 16 + 8 + h]), ii = expf(G[row * 16 + h]);
        const float vv = vs[ch]; float pn = 0.f;
#pragma unroll
        for (int j = 0; j < 64; ++j) { const int d = isk * 64 + j; C[j] = f * C[j] + ii * ks[d] * vv; pn += qs[d] * C[j]; }
        part[isk][ch] = pn;
        float dp = 0.f;
        if (!isk) { nst = f * nst + ii * ks[ch]; dp = qs[ch] * nst; }
        dp = wave_sum(dp); if (lane == 0) red[0][wave] = dp;
        __syncthreads();
        float hv = 0.f;
        if (!isk) { const float num = part[0][ch] + part[1][ch], den = red[0][0] + red[0][1]; hv = num / fmaxf(fabsf(den), 1.0f); }
        const float s1 = wave_sum(hv), s2 = wave_sum(hv * hv);
        if (lane == 0) { red[1][wave] = s1; red[2][wave] = s2; }
        __syncthreads();
        if (!isk) { const float mu = (red[1][0] + red[1][1]) * (1.f / 128.f), var = (red[2][0] + red[2][1]) * (1.f / 128.f) - mu * mu;
            const size_t a = row * DM + h * 128 + ch;
            OZ[a] = (bf16)f2bf((hv - mu) / sqrtf(var + 1e-5f) * mw * bf2f(OZ[a])); }
    }
}


__device__ __forceinline__ float dot_bf(const bf16* a, const bf16* b, int n) { float s = 0.f; for (int i = 0; i < n; ++i) s += bf2f(a[i]) * bf2f(b[i]); return s; }
__device__ __forceinline__ float sigm(float x) { return 1.0f / (1.0f + expf(-x)); }
__device__ __forceinline__ bool bad(float got, float ref) { return !(fabsf(got - ref) <= 0.03f * fabsf(ref) + 0.03f); }
__global__ void __launch_bounds__(256) chk_kernel(int which, Args args) {
    unsigned char* ws = args.ws; unsigned* fail = (unsigned*)(ws + WS_CTL) + 1024;
    const unsigned sidx = blockIdx.x * 256 + threadIdx.x;
    unsigned hsh = sidx * 2654435761u + 12345u; hsh ^= hsh >> 15; hsh *= 2246822519u; hsh ^= hsh >> 13;
    int row = hsh % M; int col = (hsh >> 15) % 1024;
    if (sidx < 4096) { row = (sidx & 1) ? M - 1 - (int)(sidx >> 1) % 512 : (int)(sidx >> 1) % 512; col = (sidx * 7) % 1024; }
    const bf16* XN = (const bf16*)(ws + WS_XN); const bf16* W1 = (const bf16*)(ws + WS_W1);
    bool f = false;
    if (which == 0) {
        const float* x = args.in[0]; float ss = 0.f; for (int k = 0; k < 1024; ++k) ss += x[(size_t)row * 1024 + k] * x[(size_t)row * 1024 + k];
        const float r = 1.0f / sqrtf(ss / 1024.f + 1e-6f); f = bad(bf2f(XN[(size_t)row * 1024 + col]), x[(size_t)row * 1024 + col] * r * args.in[1][col]);
        const int n = hsh % N1, k = col; const int n0 = n & ~31; const int src = w1_src_col(n0) + (n & 31);
        f = f || bad(bf2f(W1[(size_t)n * 1024 + k]), args.in[2][(size_t)k * DIN + src]);
        const bf16* WG = (const bf16*)(ws + WS_WG); const int ng = hsh % 2048; f = f || bad(bf2f(WG[(size_t)ng * 1024 + k]), args.in[2][(size_t)k * DIN + 9232 + ng]);
        const bf16* WP = (const bf16*)(ws + WS_WP); const int np = hsh % 1024; f = f || bad(bf2f(WP[(size_t)np * 1024 + k]), args.in[11][(size_t)k * 1024 + np]) || bad(bf2f(WP[(size_t)(1024 + np) * 1024 + k]), args.in[12][(size_t)k * 1024 + np]);
        const bf16* WO = (const bf16*)(ws + WS_WO); f = f || bad(bf2f(WO[(size_t)np * 1024 + k]), args.in[13][(size_t)k * 1024 + np]);
        if (f) atomicOr(fail + 0, 1u);
        const int gi = col & 15; float s = 0.f; const float* x2 = args.in[0] + (size_t)row * 1024;
        for (int k2 = 0; k2 < 1024; ++k2) s += x2[k2] * r * args.in[1][k2] * args.in[2][(size_t)k2 * DIN + 9216 + gi];
        s += args.in[8][gi]; if (gi >= 8) s = -log1pf(expf(-s));
        if (bad(((const float*)(ws + WS_G))[(size_t)row * 16 + gi], s)) atomicOr(fail + 1, 1u);
    } else if (which == 1) {
        const int g = (hsh >> 8) % 8; const bf16* xr = XN + (size_t)row * 1024;
        if (g < 7) { const bf16* buf = (g < 6) ? (const bf16*)(ws + WS_BQ) + (size_t)g * (BUF / 2) : (const bf16*)args.out;
            float d = dot_bf(xr, W1 + (size_t)(g * 1024 + col) * 1024, 1024); if (g == 0) d *= C2; if (g == 3) d = d * sigm(d);
            if (bad(bf2f(buf[(size_t)row * 1024 + col]), d)) atomicOr(fail + 2 + g, 1u);
        } else { const int t = col >> 7, w = col & 127; const float o = dot_bf(xr, W1 + (size_t)(7168 + t * 256 + w) * 1024, 1024), z = dot_bf(xr, W1 + (size_t)(7168 + t * 256 + 128 + w) * 1024, 1024);
            if (bad(bf2f(((const bf16*)args.out + (size_t)M * DM)[(size_t)row * 1024 + col]), sigm(o) * z * sigm(z))) atomicOr(fail + 9, 1u); }
    } else if (which == 2) {
        const int g = (hsh >> 8) & 1; const float d = dot_bf(XN + (size_t)row * 1024, (const bf16*)(ws + WS_WG) + (size_t)(g * 1024 + col) * 1024, 1024) + args.in[10][g * 1024 + col];
        if (bad(bf2f(((const bf16*)(ws + WS_BK) + (size_t)g * (BUF / 2))[(size_t)row * 1024 + col]), sigm(d))) atomicOr(fail + 10 + g, 1u);
    } else if (which == 3) {
        const bf16* ya = (const bf16*)(ws + WS_BQ) + (size_t)row * 1024; const bf16* ym = (const bf16*)args.out + (size_t)M * DM + (size_t)row * 1024; const bf16* WP = (const bf16*)(ws + WS_WP);
        const float ga = bf2f(((const bf16*)(ws + WS_BK))[(size_t)row * 1024 + col]), gm = bf2f(((const bf16*)(ws + WS_BV))[(size_t)row * 1024 + col]);
        const float ref = ga * dot_bf(ya, WP + (size_t)col * 1024, 1024) + gm * dot_bf(ym, WP + (size_t)(1024 + col) * 1024, 1024);
        if (bad(bf2f(((const bf16*)(ws + WS_MQ))[(size_t)row * 1024 + col]), ref)) atomicOr(fail + 12, 1u);
    } else if (which == 4) {
        const float ref = args.in[0][(size_t)row * 1024 + col] + dot_bf((const bf16*)(ws + WS_MQ) + (size_t)row * 1024, (const bf16*)(ws + WS_WO) + (size_t)col * 1024, 1024);
        if (bad(args.out[(size_t)row * 1024 + col], ref)) atomicOr(fail + 13, 1u);
    }
}
__global__ void __launch_bounds__(256) report_kernel(Args args) {
    const unsigned* fail = (const unsigned*)(args.ws + WS_CTL) + 1024; int code = 0;
    for (int i = 13; i >= 0; --i) if (fail[i]) code = i + 1;
    if (code == 0) return;
    for (size_t i = (size_t)blockIdx.x * 256 + threadIdx.x; i < (size_t)M * DM; i += (size_t)gridDim.x * 256) args.out[i] = (float)code;
}

extern "C" void kernel_launch(void* const* d_in, const int* in_sizes, int n_in, void* d_out, int out_size, void* d_ws, size_t ws_size, hipStream_t stream) {
    static int grid = 0;
    if (grid == 0) {
        if (n_in != 15 || out_size != M * DM || ws_size < WS_END) { fprintf(stderr, "kernel_launch: unexpected shapes (n_in %d out %d ws %zu)\n", n_in, out_size, ws_size); grid = -1; return; }
        int dev = 0, cus = 0;
        hipGetDevice(&dev); hipDeviceGetAttribute(&cus, hipDeviceAttributeMultiprocessorCount, dev);
        if (hipFuncSetAttribute((const void*)skel_fwd, hipFuncAttributeMaxDynamicSharedMemorySize, LDS_BYTES) != hipSuccess) { fprintf(stderr, "kernel_launch: hipFuncSetAttribute failed\n"); grid = -1; return; }
        int per_cu = 0;
        if (hipOccupancyMaxActiveBlocksPerMultiprocessor(&per_cu, (const void*)skel_fwd, NWAVES * 64, LDS_BYTES) != hipSuccess || per_cu < 1) { fprintf(stderr, "kernel_launch: occupancy query failed\n"); grid = -1; return; }
        grid = cus * per_cu;
    }
    if (grid < 0) return;
    Args a{};
    for (int i = 0; i < 15; ++i) a.in[i] = (const float*)d_in[i];
    a.out = (float*)d_out; a.ws = (unsigned char*)d_ws;
    unsigned char* ws = (unsigned char*)d_ws;
    auto run = [&](int lo, int hi) { a.ph_lo = lo; a.ph_hi = hi; hipLaunchKernelGGL(skel_fwd, dim3(grid), dim3(NWAVES * 64), LDS_BYTES, stream, a); };
    (void)hipMemsetAsync(ws + WS_CTL, 0, CTL_ZERO_BYTES, stream);
    if (ONE_LAUNCH) {
        a.ph_lo = 0; a.ph_hi = 8; void* kargs[] = {&a};
        const hipError_t e = hipLaunchCooperativeKernel((const void*)skel_fwd, dim3(grid), dim3(NWAVES * 64), kargs, LDS_BYTES, stream);
        if (e != hipSuccess) fprintf(stderr, "kernel_launch: cooperative launch failed: %s (grid %d)\n", hipGetErrorString(e), grid);
        return;
    }
#define CHK(w) do { if (SELFCHECK) hipLaunchKernelGGL(chk_kernel, dim3(256), dim3(256), 0, stream, (w), a); } while (0)
    run(0, 1); CHK(0); run(1, 2); CHK(1);
    run(2, 3); run(3, 4);
    run(4, 5); run(6, 7); run(7, 8);
}
```

```cpp
#include <hip/hip_runtime.h>
#include <hip/hip_cooperative_groups.h>
#include <cstdio>
#include <cstdint>
#ifndef DBG
#define DBG 0
#endif
#ifndef NAIVE_ATTN
#define NAIVE_ATTN 0
#endif
#ifndef NAIVE_MLSTM
#define NAIVE_MLSTM 0
#endif
#ifndef ONE_LAUNCH
#define ONE_LAUNCH 1
#endif
#ifndef USE_CG_SYNC
#define USE_CG_SYNC 0
#endif
#ifndef CG_FIRST
#define CG_FIRST 1
#endif
#ifndef REP_PHASE
#define REP_PHASE -1
#endif
#ifndef QMASK_LIGHT
#define QMASK_LIGHT 0x2bu
#define QMASK_HEAVY 0xd4u
#endif
#ifndef SELFCHECK
#define SELFCHECK 0
#endif
namespace pg8 {
#define PG8_LAS __attribute__((address_space(3)))
typedef unsigned short bf16_t;
typedef short bf16x8 __attribute__((ext_vector_type(8)));
typedef float f32x4 __attribute__((ext_vector_type(4)));
typedef unsigned u32x4 __attribute__((ext_vector_type(4)));
constexpr int BM = 256, BK = 64, HALF = 128, HTB = HALF * BK * 2  , STAGE_BYTES = 8 * HTB, NXCD = 8, WGM = 8;

__host__ __device__ __forceinline__ int lds_byte(int r, int c) { const int st = (r >> 4) * 2 + (c >> 5), rr = r & 15, cc = c & 31, ob = rr * 64 + cc * 2; return st * 1024 + (ob ^ (((ob >> 9) & 1) << 5)); }
__host__ __device__ __forceinline__ void stage_rc(int b, int& R, int& C) { const int st = b / 1024, sb = b % 1024, swz = sb ^ (((sb >> 9) & 1) << 5); R = (st >> 1) * 16 + swz / 64; C = (st & 1) * 32 + (swz % 64) / 2; }
__host__ __device__ __forceinline__ int perm32(int rho) { const int n = rho >> 4, i = rho & 15; return 8 * (i >> 2) + 4 * n + (i & 3); }

struct Unit { int pm, pn, pb, side; };
struct Gemm { const bf16_t* A; const bf16_t* A1; const bf16_t* A2; const bf16_t* Bt; int M, N, K; };

struct StaticOrder {
    int nM, nN, nwg, G, c;
    __host__ __device__ void init(int M, int N, int G_, int c_) { nM = M / BM; nN = N / BM; nwg = nM * nN; G = G_; c = c_; }
    __host__ __device__ bool next(int i, Unit& u) const {
        const long L = (long)i * G + c; if (L >= nwg) return false;
        int wgid = (int)L; { const int q = nwg / NXCD, r = nwg % NXCD, xcd = wgid % NXCD, off = wgid / NXCD; wgid = (xcd < r ? xcd * (q + 1) : r * (q + 1) + (xcd - r) * q) + off; }
        const int nig = WGM * nN, gid = wgid / nig, fm = gid * WGM, gsz = (nM - fm) < WGM ? (nM - fm) : WGM;
        u.pm = fm + ((wgid % nig) % gsz); u.pn = (wgid % nig) / gsz; u.pb = u.pn; u.side = 0; return true;
    }
    __device__ __forceinline__ void a_ready(const Unit&) const {}
    __device__ __forceinline__ void done(const Unit&) const {}
};


typedef float f32x2_t __attribute__((ext_vector_type(2))); typedef __bf16 bf16x2_t __attribute__((ext_vector_type(2)));
__device__ __forceinline__ unsigned cvt_pk_bf16(float lo, float hi) { f32x2_t v = {lo, hi}; bf16x2_t b = __builtin_convertvector(v, bf16x2_t); return __builtin_bit_cast(unsigned, b); }
__device__ __forceinline__ float sigmoid_f(float x) { return __builtin_amdgcn_rcpf(1.0f + __builtin_amdgcn_exp2f(-1.4426950408889634f * x)); }
__device__ __forceinline__ float silu_f(float x) { return x * sigmoid_f(x); }
__device__ __forceinline__ f32x4 bf4_lo(unsigned a, unsigned b) { return (f32x4){__uint_as_float(a << 16), __uint_as_float(a & 0xffff0000u), __uint_as_float(b << 16), __uint_as_float(b & 0xffff0000u)}; }
__device__ __forceinline__ u32x4 pack8(f32x4 v0, f32x4 v1) { u32x4 w; w.x = cvt_pk_bf16(v0[0], v0[1]); w.y = cvt_pk_bf16(v0[2], v0[3]); w.z = cvt_pk_bf16(v1[0], v1[1]); w.w = cvt_pk_bf16(v1[2], v1[3]); return w; }

struct EpiP1 {
    static constexpr bool PERM = true, AFTER_DRAIN = false;
    bf16_t* g0; size_t gstride; bf16_t* mv; bf16_t* oz; float c2;
    __device__ __forceinline__ void operator()(const f32x4 (&acc)[2][2][4][2], const Unit& u, int wr, int wc, int fr, int fq) const {
        const int row0 = u.pm * BM + wr * 64 + fr;
        if (u.pn < 28) {
            const int g = u.pn >> 2; bf16_t* base = (g < 6) ? g0 + (size_t)g * gstride : mv;
            const int col0 = (u.pn & 3) * BM + wc * 32 + 8 * fq;
            const float sc = (g == 0) ? c2 : 1.0f; const bool act = (g == 3);
#pragma unroll
            for (int ai = 0; ai < 2; ++ai)
#pragma unroll
                for (int m = 0; m < 4; ++m) { bf16_t* rowp = base + (size_t)(row0 + ai * HALF + m * 16) * 1024 + col0;
#pragma unroll
                    for (int bj = 0; bj < 2; ++bj) { f32x4 v0 = acc[ai][bj][m][0] * sc, v1 = acc[ai][bj][m][1] * sc;
                        if (act) {
#pragma unroll
                            for (int e = 0; e < 4; ++e) { v0[e] = silu_f(v0[e]); v1[e] = silu_f(v1[e]); } }
                        *(u32x4*)(rowp + bj * HALF) = pack8(v0, v1); } }
        } else {
            const int col0 = (u.pn - 28) * HALF + wc * 32 + 8 * fq;
#pragma unroll
            for (int ai = 0; ai < 2; ++ai)
#pragma unroll
                for (int m = 0; m < 4; ++m) { bf16_t* rowp = oz + (size_t)(row0 + ai * HALF + m * 16) * 1024 + col0; f32x4 v0, v1;
#pragma unroll
                    for (int e = 0; e < 4; ++e) { v0[e] = sigmoid_f(acc[ai][0][m][0][e]) * silu_f(acc[ai][1][m][0][e]); v1[e] = sigmoid_f(acc[ai][0][m][1][e]) * silu_f(acc[ai][1][m][1][e]); }
                    *(u32x4*)rowp = pack8(v0, v1); }
        }
    }
};
struct EpiGate {
    static constexpr bool PERM = true, AFTER_DRAIN = false;
    bf16_t* ga; size_t gstride; const float* bias;
    __device__ __forceinline__ void operator()(const f32x4 (&acc)[2][2][4][2], const Unit& u, int wr, int wc, int fr, int fq) const {
        const int row0 = u.pm * BM + wr * 64 + fr; const int g = u.pn >> 2; bf16_t* base = ga + (size_t)g * gstride;
        const int col0 = (u.pn & 3) * BM + wc * 32 + 8 * fq;
        f32x4 bv[2][2];
#pragma unroll
        for (int bj = 0; bj < 2; ++bj)
#pragma unroll
            for (int n = 0; n < 2; ++n) bv[bj][n] = *(const f32x4*)(bias + g * 1024 + col0 + bj * HALF + 4 * n);
#pragma unroll
        for (int ai = 0; ai < 2; ++ai)
#pragma unroll
            for (int m = 0; m < 4; ++m) { bf16_t* rowp = base + (size_t)(row0 + ai * HALF + m * 16) * 1024 + col0;
#pragma unroll
                for (int bj = 0; bj < 2; ++bj) { f32x4 v0 = acc[ai][bj][m][0] + bv[bj][0], v1 = acc[ai][bj][m][1] + bv[bj][1];
#pragma unroll
                    for (int e = 0; e < 4; ++e) { v0[e] = sigmoid_f(v0[e]); v1[e] = sigmoid_f(v1[e]); }
                    *(u32x4*)(rowp + bj * HALF) = pack8(v0, v1); } }
    }
};
struct EpiMerge {
    static constexpr bool PERM = true, AFTER_DRAIN = false;
    const bf16_t* ga; const bf16_t* gm; bf16_t* tb; bf16_t* mb;
    __device__ __forceinline__ void operator()(const f32x4 (&acc)[2][2][4][2], const Unit& u, int wr, int wc, int fr, int fq) const {
        const int row0 = u.pm * BM + wr * 64 + fr; const int col0 = u.pn * BM + wc * 32 + 8 * fq;
        const bf16_t* gp = u.side ? gm : ga;
#pragma unroll
        for (int ai = 0; ai < 2; ++ai)
#pragma unroll
            for (int m = 0; m < 4; ++m) { const size_t off = (size_t)(row0 + ai * HALF + m * 16) * 1024 + col0;
#pragma unroll
                for (int bj = 0; bj < 2; ++bj) { const u32x4 gw = *(const u32x4*)(gp + off + bj * HALF);
                    f32x4 v0 = acc[ai][bj][m][0] * bf4_lo(gw.x, gw.y), v1 = acc[ai][bj][m][1] * bf4_lo(gw.z, gw.w);
                    if (u.side) { const u32x4 tw = *(const u32x4*)(tb + off + bj * HALF); if (DBG == 1) { v0 = bf4_lo(tw.x, tw.y); v1 = bf4_lo(tw.z, tw.w); } else if (DBG != 2) { v0 += bf4_lo(tw.x, tw.y); v1 += bf4_lo(tw.z, tw.w); } *(u32x4*)(mb + off + bj * HALF) = pack8(v0, v1); }
                    else *(u32x4*)(tb + off + bj * HALF) = pack8(v0, v1); } }
    }
};
struct EpiRes {
    static constexpr bool PERM = false, AFTER_DRAIN = false;
    const float* base; float* out;
    __device__ __forceinline__ void operator()(const f32x4 (&acc)[2][2][4][2], const Unit& u, int wr, int wc, int fr, int fq) const {
        const int row0 = u.pm * BM + wr * 64 + fr; const int col0 = u.pn * BM + wc * 32 + 4 * fq;
#pragma unroll
        for (int ai = 0; ai < 2; ++ai)
#pragma unroll
            for (int m = 0; m < 4; ++m) { const size_t off = (size_t)(row0 + ai * HALF + m * 16) * 1024 + col0;
#pragma unroll
                for (int bj = 0; bj < 2; ++bj)
#pragma unroll
                    for (int n = 0; n < 2; ++n) { const f32x4 bs = *(const f32x4*)(base + off + bj * HALF + n * 16); *(f32x4*)(out + off + bj * HALF + n * 16) = bs + acc[ai][bj][m][n]; } }
    }
};
struct EpiGM {
    static constexpr bool PERM = true, AFTER_DRAIN = false;
    bf16_t* ga; bf16_t* gm; bf16_t* tb; bf16_t* mb; const float* bias;
    __device__ __forceinline__ void operator()(const f32x4 (&acc)[2][2][4][2], const Unit& u, int wr, int wc, int fr, int fq) const {
        const int row0 = u.pm * BM + wr * 64 + fr; const int col0 = u.pn * BM + wc * 32 + 8 * fq; const int kind = u.pb >> 2;
        if (kind < 2) {
            bf16_t* base = kind ? gm : ga; f32x4 bv[2][2];
#pragma unroll
            for (int bj = 0; bj < 2; ++bj)
#pragma unroll
                for (int n = 0; n < 2; ++n) bv[bj][n] = *(const f32x4*)(bias + kind * 1024 + col0 + bj * HALF + 4 * n);
#pragma unroll
            for (int ai = 0; ai < 2; ++ai)
#pragma unroll
                for (int m = 0; m < 4; ++m) { bf16_t* rowp = base + (size_t)(row0 + ai * HALF + m * 16) * 1024 + col0;
#pragma unroll
                    for (int bj = 0; bj < 2; ++bj) { f32x4 v0 = acc[ai][bj][m][0] + bv[bj][0], v1 = acc[ai][bj][m][1] + bv[bj][1];
#pragma unroll
                        for (int e = 0; e < 4; ++e) { v0[e] = sigmoid_f(v0[e]); v1[e] = sigmoid_f(v1[e]); }
                        *(u32x4*)(rowp + bj * HALF) = pack8(v0, v1); } }
        } else {
            const bf16_t* gp = (kind == 3) ? gm : ga;
#pragma unroll
            for (int ai = 0; ai < 2; ++ai)
#pragma unroll
                for (int m = 0; m < 4; ++m) { const size_t off = (size_t)(row0 + ai * HALF + m * 16) * 1024 + col0;
#pragma unroll
                    for (int bj = 0; bj < 2; ++bj) { const u32x4 gw = *(const u32x4*)(gp + off + bj * HALF);
                        f32x4 v0 = acc[ai][bj][m][0] * bf4_lo(gw.x, gw.y), v1 = acc[ai][bj][m][1] * bf4_lo(gw.z, gw.w);
                        if (kind == 3) { const u32x4 tw = *(const u32x4*)(tb + off + bj * HALF); v0 += bf4_lo(tw.x, tw.y); v1 += bf4_lo(tw.z, tw.w); *(u32x4*)(mb + off + bj * HALF) = pack8(v0, v1); }
                        else *(u32x4*)(tb + off + bj * HALF) = pack8(v0, v1); } }
        }
    }
};
struct QuadOrder {
    StaticOrder so;
    __device__ void init(int M, int N, int G_, int c_) { so.init(M, N, G_, c_); }
    __device__ bool next(int i, Unit& u) const { if (!so.next(i >> 2, u)) return false; const int k = i & 3; u.pb = u.pn + 4 * k; u.side = (k < 2) ? 0 : k - 1; return true; }
    __device__ __forceinline__ void a_ready(const Unit&) const {}
    __device__ __forceinline__ void done(const Unit&) const {}
};
struct RepOrder {
    StaticOrder so; int cnt, reps;
    __device__ void init(int M, int N, int G_, int c_, int reps_) { so.init(M, N, G_, c_); cnt = (so.nwg - c_ + G_ - 1) / G_; reps = reps_; }
    __device__ bool next(int i, Unit& u) const { if (i >= cnt * reps) return false; return so.next(i % cnt, u); }
    __device__ __forceinline__ void a_ready(const Unit&) const {}
    __device__ __forceinline__ void done(const Unit&) const {}
};
struct PairOrder {
    StaticOrder so;
    __device__ void init(int M, int N, int G_, int c_) { so.init(M, N, G_, c_); }
    __device__ bool next(int i, Unit& u) const { if (!so.next(i >> 1, u)) return false; u.side = i & 1; u.pb = u.pn + (u.side ? so.nN : 0); return true; }
    __device__ __forceinline__ void a_ready(const Unit&) const {}
    __device__ __forceinline__ void done(const Unit&) const {}
};

template <class Epi, class Sched, bool ALIGN_EPI = false, bool SP2 = false>
__device__ __forceinline__ void gemm_phase(PG8_LAS unsigned char* lds, const Gemm g, const Sched& S, const Epi& E) {
    const int tid = threadIdx.x, wid = __builtin_amdgcn_readfirstlane(tid >> 6), lane = tid & 63, wr = wid >> 2, wc = wid & 3, fr = lane & 15, fq = lane >> 4;
    const int K = g.K, nt = K / BK;
    unsigned voffA[2], voffB[2];
#pragma unroll
    for (int i = 0; i < 2; ++i) { int R, C; stage_rc(tid * 16 + i * 8192, R, C); const int Rb = Epi::PERM ? ((R & ~31) + perm32(R & 31)) : R;
        voffA[i] = (unsigned)(R * K + C) * 2u; voffB[i] = (unsigned)(Rb * K + C) * 2u; }
    const size_t kstep = (size_t)(BK * 2);
    const size_t hstep = (size_t)HALF * K * 2;
    const size_t tstep = 2 * hstep;
    const unsigned ldsw = (unsigned)wid * 1024u;
    const int aoff = lds_byte(wr * 64 + fr, fq * 8), boff = lds_byte(wc * 32 + fr, fq * 8);
#define PG8_SA(b, h) (((b) * 2 + (h)) * HTB)
#define PG8_SB(b, h) ((4 + (b) * 2 + (h)) * HTB)
#define PG8_STAGE(bufoff, gbase, voff) do { _Pragma("unroll") for (int _i = 0; _i < 2; ++_i) \
        __builtin_amdgcn_global_load_lds((const unsigned*)((const char*)(gbase) + (voff)[_i]), (PG8_LAS unsigned*)(lds + (bufoff) + ldsw + _i * 8192), 16, 0, 0); } while (0)
#define PG8_LDA(dst, b, h) do { _Pragma("unroll") for (int m = 0; m < 4; ++m) _Pragma("unroll") for (int k = 0; k < 2; ++k) dst[m][k] = *(const PG8_LAS bf16x8*)(lds + PG8_SA(b, h) + aoff + m * 2048 + k * 1024); } while (0)
#define PG8_LDB(dst, b, h) do { _Pragma("unroll") for (int n = 0; n < 2; ++n) _Pragma("unroll") for (int k = 0; k < 2; ++k) dst[n][k] = *(const PG8_LAS bf16x8*)(lds + PG8_SB(b, h) + boff + n * 2048 + k * 1024); } while (0)
#define PG8_MMA(ai, bj, At, Bt) do { __builtin_amdgcn_s_setprio(1); _Pragma("unroll") for (int m = 0; m < 4; ++m) _Pragma("unroll") for (int n = 0; n < 2; ++n) _Pragma("unroll") for (int k = 0; k < 2; ++k) \
        acc[ai][bj][m][n] = __builtin_amdgcn_mfma_f32_16x16x32_bf16(Bt[n][k], At[m][k], acc[ai][bj][m][n], 0, 0, 0); __builtin_amdgcn_s_setprio(0); } while (0)
#define PG8_WAIT_V(n) asm volatile("s_waitcnt vmcnt(" #n ")" ::: "memory")
#define PG8_WAIT_L(n) asm volatile("s_waitcnt lgkmcnt(" #n ")" ::: "memory")
#define PG8_BAR __builtin_amdgcn_s_barrier()
#define PG8_SCHED __builtin_amdgcn_sched_barrier(0)
    Unit cur, nxt; int ui = 0;
    if (!S.next(0, cur)) return;
    f32x4 acc[2][2][4][2];
#pragma unroll
    for (int a = 0; a < 2; ++a)
#pragma unroll
        for (int b = 0; b < 2; ++b)
#pragma unroll
            for (int m = 0; m < 4; ++m)
#pragma unroll
                for (int n = 0; n < 2; ++n) acc[a][b][m][n] = (f32x4){0.f, 0.f, 0.f, 0.f};
    bf16x8 At[4][2], B0[2][2], B1[2][2];
    const char* cA = (const char*)(cur.side == 0 ? g.A : (cur.side == 1 ? g.A1 : g.A2)) + (size_t)cur.pm * tstep; const char* cB = (const char*)g.Bt + (size_t)cur.pb * tstep;
    S.a_ready(cur);
    if constexpr (SP2) {
        PG8_STAGE(PG8_SB(0, 0), cB, voffB); PG8_STAGE(PG8_SB(0, 1), cB + hstep, voffB); PG8_STAGE(PG8_SA(0, 0), cA, voffA); PG8_STAGE(PG8_SA(0, 1), cA + hstep, voffA);
        if (wr == 1) PG8_BAR;
        PG8_WAIT_V(2); PG8_BAR;
        PG8_STAGE(PG8_SB(1, 0), cB + kstep, voffB); PG8_STAGE(PG8_SA(1, 0), cA + kstep, voffA); PG8_STAGE(PG8_SB(1, 1), cB + hstep + kstep, voffB);
        PG8_WAIT_V(6); PG8_BAR;
    } else {
        PG8_STAGE(PG8_SB(0, 0), cB, voffB); PG8_STAGE(PG8_SA(0, 0), cA, voffA); PG8_STAGE(PG8_SB(0, 1), cB + hstep, voffB); PG8_STAGE(PG8_SA(0, 1), cA + hstep, voffA);
        if (wr == 1) PG8_BAR;
        PG8_WAIT_V(4); PG8_BAR;
        PG8_STAGE(PG8_SB(1, 0), cB + kstep, voffB); PG8_STAGE(PG8_SA(1, 0), cA + kstep, voffA); PG8_STAGE(PG8_SB(1, 1), cB + hstep + kstep, voffB);
        PG8_WAIT_V(6); PG8_BAR;
    }
    for (;;) {
        const bool has_next = S.next(ui + 1, nxt);
        const char* nA = has_next ? (const char*)(nxt.side == 0 ? g.A : (nxt.side == 1 ? g.A1 : g.A2)) + (size_t)nxt.pm * tstep : cA; const char* nB = has_next ? (const char*)g.Bt + (size_t)nxt.pb * tstep : cB;
        for (int t = 0; t < nt; t += 2) {
            const bool last = (t == nt - 2);
            const char* a1 = cA + (size_t)(t + 1) * kstep;
            const char* a2 = last ? nA : cA + (size_t)(t + 2) * kstep; const char* b2 = last ? nB : cB + (size_t)(t + 2) * kstep;
            const char* a3 = a2 + kstep; const char* b3 = b2 + kstep;
            if (last && has_next) S.a_ready(nxt);
            if constexpr (SP2) {
            PG8_LDB(B0, 0, 0); PG8_LDB(B1, 0, 1); PG8_SCHED; PG8_LDA(At, 0, 0); PG8_STAGE(PG8_SA(1, 1), a1 + hstep, voffA);
            PG8_WAIT_V(8); PG8_WAIT_L(0); PG8_BAR; PG8_MMA(0, 0, At, B0); PG8_MMA(0, 1, At, B1); PG8_BAR; PG8_SCHED;
            PG8_LDA(At, 0, 1); PG8_STAGE(PG8_SB(0, 0), b2, voffB); PG8_STAGE(PG8_SB(0, 1), b2 + hstep, voffB); PG8_STAGE(PG8_SA(0, 0), a2, voffA);
            PG8_WAIT_V(8); PG8_WAIT_L(0); PG8_BAR; PG8_MMA(1, 0, At, B0); PG8_MMA(1, 1, At, B1); PG8_BAR; PG8_SCHED;
            PG8_LDB(B0, 1, 0); PG8_LDB(B1, 1, 1); PG8_SCHED; PG8_LDA(At, 1, 0); PG8_STAGE(PG8_SA(0, 1), a2 + hstep, voffA);
            PG8_WAIT_V(8); PG8_WAIT_L(0); PG8_BAR; PG8_MMA(0, 0, At, B0); PG8_MMA(0, 1, At, B1); PG8_BAR; PG8_SCHED;
            PG8_LDA(At, 1, 1); PG8_STAGE(PG8_SB(1, 0), b3, voffB); PG8_STAGE(PG8_SB(1, 1), b3 + hstep, voffB); PG8_STAGE(PG8_SA(1, 0), a3, voffA);
            PG8_WAIT_V(8); PG8_WAIT_L(0); PG8_BAR; PG8_MMA(1, 0, At, B0); PG8_MMA(1, 1, At, B1); PG8_BAR; PG8_SCHED;
            } else {
            PG8_LDB(B0, 0, 0); PG8_SCHED; PG8_LDA(At, 0, 0); PG8_STAGE(PG8_SA(1, 1), a1 + hstep, voffA);
            PG8_WAIT_L(8); PG8_BAR; PG8_WAIT_L(0); PG8_MMA(0, 0, At, B0); PG8_BAR; PG8_SCHED;
            PG8_LDB(B1, 0, 1); PG8_STAGE(PG8_SB(0, 0), b2, voffB);
            PG8_BAR; PG8_WAIT_L(0); PG8_MMA(0, 1, At, B1); PG8_BAR;
            PG8_LDA(At, 0, 1); PG8_STAGE(PG8_SA(0, 0), a2, voffA);
            PG8_BAR; PG8_WAIT_L(0); PG8_MMA(1, 0, At, B0); PG8_BAR; PG8_SCHED;
            PG8_STAGE(PG8_SB(0, 1), b2 + hstep, voffB);
            PG8_WAIT_V(6); PG8_BAR; PG8_MMA(1, 1, At, B1); PG8_BAR;
            PG8_LDB(B0, 1, 0); PG8_SCHED; PG8_LDA(At, 1, 0); PG8_STAGE(PG8_SA(0, 1), a2 + hstep, voffA);
            PG8_WAIT_L(8); PG8_BAR; PG8_WAIT_L(0); PG8_MMA(0, 0, At, B0); PG8_BAR; PG8_SCHED;
            PG8_LDB(B1, 1, 1); PG8_STAGE(PG8_SB(1, 0), b3, voffB);
            PG8_BAR; PG8_WAIT_L(0); PG8_MMA(0, 1, At, B1); PG8_BAR;
            PG8_LDA(At, 1, 1); PG8_STAGE(PG8_SA(1, 0), a3, voffA);
            PG8_BAR; PG8_WAIT_L(0); PG8_MMA(1, 0, At, B0); PG8_BAR; PG8_SCHED;
            PG8_STAGE(PG8_SB(1, 1), b3 + hstep, voffB);
            PG8_WAIT_V(6); PG8_BAR; PG8_MMA(1, 1, At, B1); PG8_BAR;
            }
        }
        if constexpr (ALIGN_EPI) { if (wr == 0) PG8_BAR; }
        if constexpr (!Epi::AFTER_DRAIN) { E(acc, cur, wr, wc, fr, fq); S.done(cur); }
        if (!has_next) break;
#pragma unroll
        for (int a = 0; a < 2; ++a)
#pragma unroll
            for (int b = 0; b < 2; ++b)
#pragma unroll
                for (int m = 0; m < 4; ++m)
#pragma unroll
                    for (int n = 0; n < 2; ++n) acc[a][b][m][n] = (f32x4){0.f, 0.f, 0.f, 0.f};
        cur = nxt; cA = nA; cB = nB; ++ui;
        if constexpr (ALIGN_EPI) { if (wr == 1) PG8_BAR; }
    }
    PG8_WAIT_V(0);
    if constexpr (!ALIGN_EPI) { if (wr == 0) PG8_BAR; }
    PG8_BAR;
    if constexpr (Epi::AFTER_DRAIN) { E.fused(acc, cur, wr, wc, fr, fq, lds, wid, lane); S.done(cur); }
#undef PG8_SA
#undef PG8_SB
#undef PG8_STAGE
#undef PG8_LDA
#undef PG8_LDB
#undef PG8_MMA
#undef PG8_WAIT_V
#undef PG8_WAIT_L
#undef PG8_BAR
#undef PG8_SCHED
}
}

#include <hip/hip_bf16.h>
#include <cmath>
namespace attn_body {
using bf16=__hip_bfloat16;
using bf16x8=__attribute__((ext_vector_type(8)))short;
using s16x4=__attribute__((ext_vector_type(4)))short;
using f32x16=__attribute__((ext_vector_type(16)))float;
using u32x4=__attribute__((ext_vector_type(4)))unsigned;
constexpr int BATCH=16,SEQ=2048,D=64,DM=1024;
constexpr int NW=8,QBLK=32,QB=QBLK*NW,KVBLK=64,NQB=SEQ/QB;
constexpr int ATTN_PITCH=DM, ATTN_UNIT_ROWS=QB;
__device__ __forceinline__ int crow(int r,int hi){return (r&3)+8*(r>>2)+4*hi;}
#define SBAR() __builtin_amdgcn_sched_barrier(0)
__device__ __forceinline__ void cmask(f32x16&p0,f32x16&p1,int jb,int qrel,int hi){
  const float NEG=-INFINITY; int kb=64*jb+4*hi;
  #pragma unroll
  for(int r=0;r<16;++r){int kv=kb+(r&3)+8*(r>>2); if(kv>qrel)p0[r]=NEG; if(kv+32>qrel)p1[r]=NEG;}
}

constexpr int NSLOT=3, SLOTB=8192;
constexpr int LDS_K=0, LDS_V=NSLOT*SLOTB, LDS_WS=2*NSLOT*SLOTB, LDS_OST=LDS_WS+NW*64*4, LDS_TAB=LDS_OST+NW*8192, LDS_BYTES=LDS_TAB+1024;
constexpr float C2=0.125f*1.4426950408889634f;
__device__ __forceinline__ void glds16(const void*gsrc,unsigned lds_dst){unsigned keep;
  asm volatile("s_mov_b32 %0, m0\n\ts_mov_b32 m0, %2\n\ts_nop 0\n\tglobal_load_lds_dwordx4 %1, off\n\ts_mov_b32 m0, %0":"=&s"(keep):"v"(gsrc),"s"(lds_dst):"memory");}
__device__ __forceinline__ float max3f(float a,float b,float c){float r;asm("v_max3_f32 %0, %1, %2, %3":"=v"(r):"v"(a),"v"(b),"v"(c));return r;}
__device__ __forceinline__ float max2f(float a,float b){float r;asm("v_max_f32_e32 %0, %1, %2":"=v"(r):"v"(a),"v"(b));return r;}
__device__ __forceinline__ float fadd_s(float a,float b){float r;asm("v_add_f32_e32 %0, %1, %2":"=v"(r):"v"(a),"v"(b));return r;}
__device__ __forceinline__ float fsub_s(float a,float b){float r;asm("v_sub_f32_e32 %0, %1, %2":"=v"(r):"v"(a),"v"(b));return r;}
typedef float f32x2_t __attribute__((ext_vector_type(2))); typedef __bf16 bf16x2_t __attribute__((ext_vector_type(2)));
__device__ __forceinline__ unsigned cvtpk_s(float lo,float hi){f32x2_t v={lo,hi};bf16x2_t b=__builtin_convertvector(v,bf16x2_t);return __builtin_bit_cast(unsigned,b);}
#define WAIT_BAR(N) asm volatile("s_waitcnt vmcnt(" #N ") lgkmcnt(0)\n\ts_barrier":::"memory")

__device__ __forceinline__ void qkt(f32x16&p0,f32x16&p1,const char*Kslot,const bf16x8*qr,int r32,int hi){
  const char*kb=Kslot+hi*1024+r32*16;
  #pragma unroll
  for(int d0=0;d0<4;++d0){
    const bf16x8 b0=*reinterpret_cast<const bf16x8*>(kb+d0*2048);
    const bf16x8 b1=*reinterpret_cast<const bf16x8*>(kb+d0*2048+512);
    {p0=__builtin_amdgcn_mfma_f32_32x32x16_bf16(b0,qr[d0],p0,0,0,0);p1=__builtin_amdgcn_mfma_f32_32x32x16_bf16(b1,qr[d0],p1,0,0,0);}}
}
typedef __attribute__((address_space(3))) const char* lds_cptr;
typedef short v4i16_t __attribute__((ext_vector_type(4)));
__device__ __forceinline__ void kload8(bf16x8*kf,lds_cptr kp){
  kf[0]=*(const __attribute__((address_space(3))) bf16x8*)(kp);      kf[1]=*(const __attribute__((address_space(3))) bf16x8*)(kp+512);
  kf[2]=*(const __attribute__((address_space(3))) bf16x8*)(kp+2048); kf[3]=*(const __attribute__((address_space(3))) bf16x8*)(kp+2560);
  kf[4]=*(const __attribute__((address_space(3))) bf16x8*)(kp+4096); kf[5]=*(const __attribute__((address_space(3))) bf16x8*)(kp+4608);
  kf[6]=*(const __attribute__((address_space(3))) bf16x8*)(kp+6144); kf[7]=*(const __attribute__((address_space(3))) bf16x8*)(kp+6656);
}
__device__ __forceinline__ void kload2(bf16x8*kf,lds_cptr kp,int j){ kf[2*j]=*(const __attribute__((address_space(3))) bf16x8*)(kp+j*2048); kf[2*j+1]=*(const __attribute__((address_space(3))) bf16x8*)(kp+j*2048+512); }
__device__ __forceinline__ s16x4 vtr(lds_cptr p){ return __builtin_bit_cast(s16x4,__builtin_amdgcn_ds_read_tr16_b64_v4i16((__attribute__((address_space(3))) v4i16_t*)p)); }
__device__ __forceinline__ float rowmax(const f32x16&p0,const f32x16&p1){
  float a=max3f(p0[0],p0[1],p1[0]),b=max3f(p0[2],p0[3],p1[1]);a=max3f(a,p1[2],p1[3]);
  #pragma unroll
  for(int r=4;r<16;r+=4){a=max3f(a,p0[r],p0[r+1]);b=max3f(b,p0[r+2],p0[r+3]);a=max3f(a,p1[r],p1[r+1]);b=max3f(b,p1[r+2],p1[r+3]);}
  const float m=max2f(a,b);
  auto rr=__builtin_amdgcn_permlane32_swap(__float_as_uint(m),__float_as_uint(m),false,false);
  return max2f(__uint_as_float(rr[0]),__uint_as_float(rr[1]));
}
__device__ __forceinline__ void pv(f32x16*o,int vb,bf16x8 pa0,bf16x8 pa1,bf16x8 pa2,bf16x8 pa3){
  #pragma unroll
  for(int d0=0;d0<2;++d0){s16x4 lo[4],hi[4];
    #pragma unroll
    for(int ks=0;ks<4;++ks){
      asm volatile("ds_read_b64_tr_b16 %0,%1 offset:%c2":"=&v"(lo[ks]):"v"(vb),"i"(d0*4096+ks*1024):"memory");
      asm volatile("ds_read_b64_tr_b16 %0,%1 offset:%c2":"=&v"(hi[ks]):"v"(vb),"i"(d0*4096+ks*1024+512):"memory");}
    asm volatile("s_waitcnt lgkmcnt(0)":::"memory");SBAR();
    #define PK(k) (bf16x8){lo[k][0],lo[k][1],lo[k][2],lo[k][3],hi[k][0],hi[k][1],hi[k][2],hi[k][3]}
    o[d0]=__builtin_amdgcn_mfma_f32_32x32x16_bf16(pa0,PK(0),o[d0],0,0,0);
    o[d0]=__builtin_amdgcn_mfma_f32_32x32x16_bf16(pa1,PK(1),o[d0],0,0,0);
    o[d0]=__builtin_amdgcn_mfma_f32_32x32x16_bf16(pa2,PK(2),o[d0],0,0,0);
    o[d0]=__builtin_amdgcn_mfma_f32_32x32x16_bf16(pa3,PK(3),o[d0],0,0,0);
    #undef PK
  }
}

#ifndef ATTN_STORE16
#define ATTN_STORE16(p,v) (*(u32x4*)(p)=(v))
#endif
template<int THRL> __device__ __forceinline__ void attn_pass(int b,int h,int qb,int p,int vh,const bf16*Q,const bf16*K,const bf16*V,const bf16*SZ,bf16*Y,float*spill,float lam,const float*subln_w,char*shm,bool dry){
  int tid=threadIdx.x; asm volatile("":"+v"(tid));
  const int lane=tid&63,r32=lane&31,hi=lane>>5; const int wid=__builtin_amdgcn_readfirstlane(tid>>6);
  const long rowbase=(long)b*SEQ; const int q0=qb*QB;
  const bf16*Qw=Q+(rowbase+q0+wid*QBLK)*DM+h*128+p*64;
  const bf16*Kh=K+rowbase*DM+h*128+p*64,*Vh=V+rowbase*DM+h*128+vh*64;
  const int cw=4*qb+(wid>>1), qmin=q0+wid*QBLK; const float*tabf=(const float*)(shm+LDS_TAB);
  const unsigned lds0=(unsigned)(uintptr_t)shm;
  float*wsf=(float*)(shm+LDS_WS)+wid*64;
  const bf16*ksrc=Kh+(long)lane*DM+wid*8;
  const bf16*vsrc=Vh+(long)(16*(wid&3)+(lane>>2))*DM+(wid>>2)*32+(lane&3)*8;
  const unsigned kdst=lds0+LDS_K+wid*1024, vdst=lds0+LDS_V+wid*1024;
  #define DMA_K(t,slot) glds16(ksrc+(long)(t)*KVBLK*DM,(unsigned)__builtin_amdgcn_readfirstlane(kdst+(slot)))
  #define DMA_V(t,slot) glds16(vsrc+(long)(t)*KVBLK*DM,(unsigned)__builtin_amdgcn_readfirstlane(vdst+(slot)))
  const int vb0=(int)(lds0+LDS_V)+((lane>>4)&1)*32+(lane&3)*8+(4*hi+((lane&15)>>2))*64;
  const char*Kbase=shm+LDS_K; bf16x8 kf[8];
  const lds_cptr shm3=(lds_cptr)shm; const lds_cptr kp0=shm3+LDS_K+hi*1024+r32*16; const lds_cptr vp0=shm3+LDS_V+((lane>>4)&1)*32+(lane&3)*8+(4*hi+((lane&15)>>2))*64;
  const int NT=(q0+QB)/KVBLK;
  DMA_K(0,0);DMA_V(0,0);DMA_K(1,SLOTB);
  bf16x8 qr[4];
  #pragma unroll
  for(int d0=0;d0<4;++d0)qr[d0]=*reinterpret_cast<const bf16x8*>(&Qw[(long)r32*DM+d0*16+hi*8]);
  float mhat=0.f,l_reg=0.f;f32x16 o[2];o[0]=f32x16{};o[1]=f32x16{};f32x16 negm; { float z_=0.f; asm volatile("":"+v"(z_)); _Pragma("unroll") for(int r=0;r<16;++r)negm[r]=z_; } asm volatile("":"+v"(negm));
  const int qrel=wid*QBLK+r32;
  #define CMASK(P0,P1,t) do{ if((t)>cw){ _Pragma("unroll") for(int r=0;r<16;++r){P0[r]=-INFINITY;P1[r]=-INFINITY;} } }while(0)
  #define BIASINIT(C0,C1,t) do{ const int base_=64*(t)-qmin; \
    if((t)<=cw && base_+63>=-90){ const float*tb_=tabf+(base_-r32+192+4*hi); \
      _Pragma("unroll") for(int r=0;r<16;++r){ const int o_=(r&3)+8*(r>>2); C0[r]=negm[r]+tb_[o_]; C1[r]=negm[r]+tb_[o_+32]; } } \
    else { _Pragma("unroll") for(int r=0;r<16;++r){ C0[r]=negm[r]; C1[r]=negm[r]; } } }while(0)
  bool resc=false;
  #define START(P0,P1) do{ const float rm=rowmax(P0,P1); resc=false; \
    { const float dl=rm; mhat=fadd_s(mhat,dl); \
      _Pragma("unroll") for(int r=0;r<16;++r){P0[r]=fsub_s(P0[r],dl);P1[r]=fsub_s(P1[r],dl);} \
      _Pragma("unroll") for(int r=0;r<16;++r)negm[r]=-mhat; asm volatile("":"+v"(negm)); } \
    _Pragma("unroll") for(int r=0;r<16;++r)P0[r]=__builtin_amdgcn_exp2f(P0[r]); }while(0)
  #define RESC() do{ if(resc){ asm volatile("s_waitcnt lgkmcnt(0)":::"memory"); \
      _Pragma("unroll") for(int d_=0;d_<2;++d_) _Pragma("unroll") for(int r=0;r<16;++r)o[d_][r]*=wsf[crow(r,hi)]; } }while(0)
  f32x16 pA0,pA1,pB0,pB1;
  int sl_prev=0,sl_cur=0,sl_next=SLOTB;
  #define ROT() do{sl_prev=sl_cur;sl_cur=sl_next;sl_next=(sl_next==(NSLOT-1)*SLOTB)?0:sl_next+SLOTB;}while(0)
  DMA_K(2,2*SLOTB);
  WAIT_BAR(3);
  BIASINIT(pA0,pA1,0); qkt(pA0,pA1,Kbase,qr,r32,hi);asm volatile("s_nop 15\n\ts_nop 7":"+v"(pA0),"+v"(pA1));CMASK(pA0,pA1,0);
  START(pA0,pA1);
  _Pragma("unroll") for(int r=0;r<16;++r)pA1[r]=__builtin_amdgcn_exp2f(pA1[r]);
  WAIT_BAR(0);
  DMA_K(3,0);DMA_V(1,SLOTB);
  ROT();
  kload8(kf,kp0+sl_cur);
  WAIT_BAR(2);
  s16x4 vlo[8],vhi[8]; u32x4 pw0,pw1,pw2,pw3;
  #define PKW(P,B) cvtpk_s(P[B],P[B+1])
  #define PAF(k) __builtin_bit_cast(bf16x8,pw##k)
  #define VFR(i) (bf16x8){vlo[i][0],vlo[i][1],vlo[i][2],vlo[i][3],vhi[i][0],vhi[i][1],vhi[i][2],vhi[i][3]}
  #define PIN(x) asm volatile("":"+v"(x))
  #define MX3(a,b,c) __builtin_fmaxf(__builtin_fmaxf((a),(b)),(c))
  #define GAPA(MF,A0,A1,A2,A3,W0,W1,PW) do{ MF; sacc+=A0; sacc+=A1; sacc+=A2; sacc+=A3; PIN(sacc); W0; W1; PIN(PW); SBAR(); }while(0)
  #define EX(v) __builtin_amdgcn_exp2f(v)
  #define GAPB(MF,X,B) do{ MF; X[B]=EX(X[B]); X[B+1]=EX(X[B+1]); X[B+2]=EX(X[B+2]); X[B+3]=EX(X[B+3]); PIN(X); SBAR(); }while(0)
  #define VRD(i) do{ vlo[i]=vtr(vp_+(((i)>>2)*4096+((i)&3)*1024)); vhi[i]=vtr(vp_+(((i)>>2)*4096+((i)&3)*1024+512)); }while(0)
  #define KRD(G,j) do{ if(G){ kload2(kf,kp0+sl_next,j); SBAR(); } }while(0)
  #define STEP(C0,C1,P0,P1,t,GK,GV,GL,CI0,CI1) do{ SBAR(); \
    const lds_cptr vp_=vp0+sl_prev; \
    VRD(0); SBAR(); float sacc=(P0[0]+P0[1]); \
    GAPA(C0=__builtin_amdgcn_mfma_f32_32x32x16_bf16(kf[0],qr[0],CI0,0,0,0), P0[2],P0[3],P0[4],P0[5],     pw0[0]=PKW(P0,0), pw0[1]=PKW(P0,2), pw0); \
    VRD(4); SBAR(); GAPA(C1=__builtin_amdgcn_mfma_f32_32x32x16_bf16(kf[1],qr[0],CI1,0,0,0), P0[6],P0[7],P0[8],P0[9],     pw0[2]=PKW(P0,4), pw0[3]=PKW(P0,6), pw0); \
    VRD(1); SBAR(); GAPA(C0=__builtin_amdgcn_mfma_f32_32x32x16_bf16(kf[2],qr[1],C0,0,0,0),   P0[10],P0[11],P0[12],P0[13], pw1[0]=PKW(P0,8), pw1[1]=PKW(P0,10), pw1); \
    VRD(5); SBAR(); GAPA(C1=__builtin_amdgcn_mfma_f32_32x32x16_bf16(kf[3],qr[1],C1,0,0,0),   P0[14],P0[15],P1[0],P1[1],   pw1[2]=PKW(P0,12),pw1[3]=PKW(P0,14), pw1); \
    VRD(2); SBAR(); GAPA(C0=__builtin_amdgcn_mfma_f32_32x32x16_bf16(kf[4],qr[2],C0,0,0,0),   P1[2],P1[3],P1[4],P1[5],     pw2[0]=PKW(P1,0), pw2[1]=PKW(P1,2), pw2); \
    VRD(6); SBAR(); GAPA(C1=__builtin_amdgcn_mfma_f32_32x32x16_bf16(kf[5],qr[2],C1,0,0,0),   P1[6],P1[7],P1[8],P1[9],     pw2[2]=PKW(P1,4), pw2[3]=PKW(P1,6), pw2); \
    VRD(3); SBAR(); GAPA(C0=__builtin_amdgcn_mfma_f32_32x32x16_bf16(kf[6],qr[3],C0,0,0,0),   P1[10],P1[11],P1[12],P1[13], pw3[0]=PKW(P1,8), pw3[1]=PKW(P1,10), pw3); \
    VRD(7); SBAR(); GAPA(C1=__builtin_amdgcn_mfma_f32_32x32x16_bf16(kf[7],qr[3],C1,0,0,0),   P1[14],P1[15],0.f,0.f,       pw3[2]=PKW(P1,12),pw3[3]=PKW(P1,14), pw3); \
    l_reg+=sacc; \
    if(GK){DMA_K((t)+3,sl_cur);} if(GV){DMA_V((t)+1,sl_next);} \
    CMASK(C0,C1,t); \
    { float a=MX3(C0[0],C0[1],C1[0]),b=MX3(C0[2],C0[3],C1[1]); a=MX3(a,C1[2],C1[3]); \
      _Pragma("unroll") for(int r=4;r<16;r+=4){a=MX3(a,C0[r],C0[r+1]);b=MX3(b,C0[r+2],C0[r+3]);a=MX3(a,C1[r],C1[r+1]);b=MX3(b,C1[r+2],C1[r+3]);} \
      float rm=__builtin_fmaxf(a,b); { auto rr=__builtin_amdgcn_permlane32_swap(__float_as_uint(rm),__float_as_uint(rm),false,false); rm=__builtin_fmaxf(__uint_as_float(rr[0]),__uint_as_float(rr[1])); } \
      resc=false; \
      if(__builtin_expect(__any(rm>(float)THRL),0)){ const float dl=__builtin_fmaxf(rm,0.f); mhat+=dl; \
        _Pragma("unroll") for(int r=0;r<16;++r){C0[r]-=dl;C1[r]-=dl;} \
        _Pragma("unroll") for(int r=0;r<16;++r)negm[r]=-mhat; asm volatile("":"+v"(negm)); \
        const float f=__builtin_amdgcn_exp2f(-dl); l_reg*=f; if(hi==0)wsf[r32]=f; resc=true; } } \
    SBAR(); \
    GAPB(o[0]=__builtin_amdgcn_mfma_f32_32x32x16_bf16(PAF(0),VFR(0),o[0],0,0,0), C0,0); \
    GAPB(o[1]=__builtin_amdgcn_mfma_f32_32x32x16_bf16(PAF(0),VFR(4),o[1],0,0,0), C0,4); \
    KRD(GL,0); GAPB(o[0]=__builtin_amdgcn_mfma_f32_32x32x16_bf16(PAF(1),VFR(1),o[0],0,0,0), C0,8); \
    KRD(GL,1); GAPB(o[1]=__builtin_amdgcn_mfma_f32_32x32x16_bf16(PAF(1),VFR(5),o[1],0,0,0), C0,12); \
    KRD(GL,2); GAPB(o[0]=__builtin_amdgcn_mfma_f32_32x32x16_bf16(PAF(2),VFR(2),o[0],0,0,0), C1,0); \
    KRD(GL,3); GAPB(o[1]=__builtin_amdgcn_mfma_f32_32x32x16_bf16(PAF(2),VFR(6),o[1],0,0,0), C1,4); \
    GAPB(o[0]=__builtin_amdgcn_mfma_f32_32x32x16_bf16(PAF(3),VFR(3),o[0],0,0,0), C1,8); \
    GAPB(o[1]=__builtin_amdgcn_mfma_f32_32x32x16_bf16(PAF(3),VFR(7),o[1],0,0,0), C1,12); \
    }while(0)
  int t=1;
  #undef CMASK
  #define CMASK(P0,P1,t) do{}while(0)
  for(;t+7<NT;t+=2){
    STEP(pB0,pB1,pA0,pA1,t,true,true,true,negm,negm);     WAIT_BAR(2); RESC(); ROT();
    STEP(pA0,pA1,pB0,pB1,t+1,true,true,true,negm,negm);   WAIT_BAR(2); RESC(); ROT();
  }
  #undef CMASK
  #define CMASK(P0,P1,t) do{ if((t)>cw){ _Pragma("unroll") for(int r=0;r<16;++r){P0[r]=-INFINITY;P1[r]=-INFINITY;} } }while(0)
  #define ENDW(tt) do{ if((tt)+3<NT){WAIT_BAR(2);} else if((tt)+2<NT){WAIT_BAR(1);} else {WAIT_BAR(0);} }while(0)
  for(;t+1<NT;t+=2){
    BIASINIT(pB0,pB1,t);   STEP(pB0,pB1,pA0,pA1,t,(t+3<NT),(t+1<NT),(t+1<NT),pB0,pB1);       ENDW(t);   RESC(); ROT();
    BIASINIT(pA0,pA1,t+1); STEP(pA0,pA1,pB0,pB1,t+1,(t+4<NT),(t+2<NT),(t+2<NT),pA0,pA1);     ENDW(t+1); RESC(); ROT();
  }
  BIASINIT(pB0,pB1,NT-1); STEP(pB0,pB1,pA0,pA1,NT-1,false,false,false,pB0,pB1); RESC();
  { float sacc=pB0[0]+pB0[1]; _Pragma("unroll") for(int r=2;r<16;++r)sacc+=pB0[r]; _Pragma("unroll") for(int r=0;r<16;++r)sacc+=pB1[r]; l_reg+=sacc;
    pw0=(u32x4){PKW(pB0,0),PKW(pB0,2),PKW(pB0,4),PKW(pB0,6)};pw1=(u32x4){PKW(pB0,8),PKW(pB0,10),PKW(pB0,12),PKW(pB0,14)};pw2=(u32x4){PKW(pB1,0),PKW(pB1,2),PKW(pB1,4),PKW(pB1,6)};pw3=(u32x4){PKW(pB1,8),PKW(pB1,10),PKW(pB1,12),PKW(pB1,14)};
    SBAR(); pv(o,vb0+sl_cur,PAF(0),PAF(1),PAF(2),PAF(3)); }
  #undef PKW
  #undef PAF
  #undef VFR
  #undef PIN
  #undef MX3
  #undef GAPA
  #undef GAPB
  #undef EX
  #undef VRD
  #undef KRD
  #undef STEP
  #undef ENDW
  {auto rr=__builtin_amdgcn_permlane32_swap(__float_as_uint(l_reg),__float_as_uint(l_reg),false,false);l_reg=__uint_as_float(rr[0])+__uint_as_float(rr[1]);}
  if(hi==0)wsf[32+r32]=l_reg;asm volatile("s_waitcnt lgkmcnt(0)":::"memory");
  int tid2=threadIdx.x; asm volatile("":"+v"(tid2)); const int lane2=tid2&63,r32b=lane2&31,hib=lane2>>5;
  float*sp=spill+((size_t)blockIdx.x*NW+wid)*2048+lane2;
  unsigned short*stg=(unsigned short*)(shm+LDS_OST)+wid*4096;
  if(p==0){
    #pragma unroll
    for(int r=0;r<16;++r){const float rl=__builtin_amdgcn_rcpf(wsf[32+crow(r,hib)]); sp[r*64]=o[0][r]*rl; sp[(16+r)*64]=o[1][r]*rl;}
  } else {
    #pragma unroll
    for(int r=0;r<16;++r){const float rl=__builtin_amdgcn_rcpf(wsf[32+crow(r,hib)]); const int orow=crow(r,hib);
      const float a0=sp[r*64]-lam*(o[0][r]*rl), a1=sp[(16+r)*64]-lam*(o[1][r]*rl);
      stg[orow*128+vh*64+r32b]=(unsigned short)(cvtpk_s(a0,0.f)&0xffffu); stg[orow*128+vh*64+32+r32b]=(unsigned short)(cvtpk_s(a1,0.f)&0xffffu);}
    if(vh==1){
      asm volatile("s_waitcnt lgkmcnt(0)":::"memory");
      const int row=lane2>>1,half=lane2&1; const unsigned short*srow=stg+row*128+half*64;
      u32x4 w[8]; float ss=0.f;
      #pragma unroll
      for(int i=0;i<8;++i){ w[i]=*(const u32x4*)(srow+i*8);
        #pragma unroll
        for(int e=0;e<4;++e){const float lo=__uint_as_float(w[i][e]<<16),hi2=__uint_as_float(w[i][e]&0xffff0000u); ss+=lo*lo+hi2*hi2;} }
      ss+=__shfl_xor(ss,1);
      const float rs=0.8f/sqrtf(ss*(1.0f/128.0f)+1e-5f);
      const size_t goff=(size_t)(rowbase+q0+wid*QBLK+row)*DM+h*128+half*64;
      #pragma unroll
      for(int i=0;i<8;++i){ const u32x4 z=*(const u32x4*)(SZ+goff+i*8); const float*swp=subln_w+half*64+i*8; u32x4 ov;
        #pragma unroll
        for(int e=0;e<4;++e){ const float a=__uint_as_float(w[i][e]<<16)*rs*swp[2*e]*__uint_as_float(z[e]<<16), c=__uint_as_float(w[i][e]&0xffff0000u)*rs*swp[2*e+1]*__uint_as_float(z[e]&0xffff0000u); ov[e]=cvtpk_s(a,c); }
        if(!dry)*(u32x4*)(Y+goff+i*8)=ov; }
    }
  }
  asm volatile("s_waitcnt lgkmcnt(0)\n\ts_barrier":::"memory");
  #undef DMA_K
  #undef DMA_V
  #undef CMASK
  #undef BIASINIT
  #undef START
  #undef RESC
  #undef ROT
}
constexpr int ATTN_LDS_BYTES=LDS_BYTES;
struct AttnTensors { const bf16* Q; const bf16* K; const bf16* V; const bf16* SZ; bf16* Y; float* spill; const float* tab; const float* subln_w; };
template<int THRL=8> __device__ __forceinline__ void attn_phase(char*lds,const AttnTensors&T,int bh,unsigned qmask,bool dry){
  const int tid=threadIdx.x; float*tabf=(float*)(lds+LDS_TAB);
  const int b=bh>>3,h=bh&7;
  for(int qb=7;qb>=0;--qb){ if(!((qmask>>qb)&1u))continue;
    if(tid<256)tabf[tid]=T.tab[h*256+tid];
    const float lam=T.tab[2048];
    for(int ps=0;ps<4;++ps) attn_pass<THRL>(b,h,qb,ps&1,ps>>1,(const bf16*)T.Q,(const bf16*)T.K,(const bf16*)T.V,T.SZ,T.Y,T.spill,lam,T.subln_w,lds,dry);
  }
}
#undef SBAR
#undef WAIT_BAR
}

namespace mlstm_body {
#define ML_LAS __attribute__((address_space(3)))
typedef unsigned short bf16_t;
typedef short bf16x8 __attribute__((ext_vector_type(8)));
typedef float f32x4 __attribute__((ext_vector_type(4)));
typedef float f32x16 __attribute__((ext_vector_type(16)));
typedef unsigned u32x4 __attribute__((ext_vector_type(4)));
typedef unsigned u32x2 __attribute__((ext_vector_type(2)));
typedef float f32x2_t __attribute__((ext_vector_type(2))); typedef __bf16 bf16x2_t __attribute__((ext_vector_type(2)));
constexpr int PQ = 272, PT = 144;
constexpr int O_Q = 0, O_KW = 17408, O_KWT = 34816, O_VT = 53248, O_S = 71680, O_CDT = 80896, O_HN = 115712, O_CONV = 133120, O_ND = 138240, O_DP = 138752, O_DI = 140800, O_CL = 141312, O_LNP = 141568, O_END = 143616;
constexpr int SEQ = 2048, DM = 1024;
struct Tensors { const bf16_t* MQ; const bf16_t* MK; const bf16_t* MV; const float* G; const float* conv_w; const float* conv_b; const float* mh_w; bf16_t* OZ; };
__device__ __forceinline__ unsigned pk(float lo, float hi) { f32x2_t v = {lo, hi}; bf16x2_t b = __builtin_convertvector(v, bf16x2_t); return __builtin_bit_cast(unsigned, b); }
__device__ __forceinline__ float blo(unsigned w) { return __uint_as_float(w << 16); }
__device__ __forceinline__ float bhi(unsigned w) { return __uint_as_float(w & 0xffff0000u); }
__device__ __forceinline__ float silu(float x) { return x * __builtin_amdgcn_rcpf(1.0f + __builtin_amdgcn_exp2f(-1.4426950408889634f * x)); }

__device__ __forceinline__ void mlstm_seq(ML_LAS unsigned char* lds, const Tensors& T, int bh, bool dry) {
    const int tid = threadIdx.x, lane = tid & 63, wid = __builtin_amdgcn_readfirstlane(tid >> 6), r32 = lane & 31, hi = lane >> 5;
    const int b = bh >> 3, h = bh & 7; const size_t row0 = (size_t)b * SEQ;
    ML_LAS float* CONV = (ML_LAS float*)(lds + O_CONV); ML_LAS float* ND = (ML_LAS float*)(lds + O_ND); ML_LAS float* DP = (ML_LAS float*)(lds + O_DP);
    ML_LAS float* DI = (ML_LAS float*)(lds + O_DI); ML_LAS float* CL = (ML_LAS float*)(lds + O_CL); ML_LAS float* LNP = (ML_LAS float*)(lds + O_LNP);
    for (int i = tid; i < 1280; i += 512) { const int ten = i / 640, j = (i % 640) >> 7, d = i & 127;
        CONV[i] = (j < 4) ? T.conv_w[(ten * 4 + j) * 1024 + h * 128 + d] : T.conv_b[ten * 1024 + h * 128 + d]; }
    const int dch = tid & 15, rg = tid >> 4;
    float mhw[8];
#pragma unroll
    for (int e = 0; e < 8; ++e) mhw[e] = T.mh_w[h * 128 + 8 * dch + e];
    f32x16 C0, C1;
#pragma unroll
    for (int r = 0; r < 16; ++r) { C0[r] = 0.f; C1[r] = 0.f; }
    float nst = 0.f, m_state = 0.f;
    __syncthreads();
    for (int c = 0; c < SEQ / 64; ++c) {
        const int t0 = 64 * c;
        const float ig = T.G[(row0 + t0 + lane) * 16 + h], lf = T.G[(row0 + t0 + lane) * 16 + 8 + h];
        float bcs = lf;
#pragma unroll
        for (int o = 1; o < 64; o <<= 1) { const float t = __shfl_up(bcs, o); if (lane >= o) bcs += t; }
        const float a = ig - bcs; float Mx = a;
#pragma unroll
        for (int o = 1; o < 64; o <<= 1) { const float t = __shfl_up(Mx, o); if (lane >= o) Mx = fmaxf(Mx, t); }
        const float mu63 = fmaxf(m_state, __shfl(Mx, 63)), blast = __shfl(bcs, 63);
        const float wsl = __expf(a - mu63), decay = __expf(m_state - mu63);
        if (wid == 0) CL[lane] = __expf(-bcs - mu63);
        m_state = blast + mu63;
        const float wsA = __shfl(wsl, 2 * rg) * 0.08838834764831845f, wsB = __shfl(wsl, 2 * rg + 1) * 0.08838834764831845f;
        u32x4 ozr[2];
        {
            const size_t gcol = (size_t)h * 128 + 8 * dch;
            u32x4 raw[2][5];
#pragma unroll
            for (int i = 0; i < 5; ++i) { const int tr = t0 + 2 * rg - 3 + i;
                if (tr >= 0) { raw[0][i] = *(const u32x4*)(T.MQ + (row0 + tr) * DM + gcol); raw[1][i] = *(const u32x4*)(T.MK + (row0 + tr) * DM + gcol); }
                else { raw[0][i] = (u32x4){0u, 0u, 0u, 0u}; raw[1][i] = (u32x4){0u, 0u, 0u, 0u}; } }
            u32x4 vr[2];
#pragma unroll
            for (int i = 0; i < 2; ++i) { vr[i] = *(const u32x4*)(T.MV + (row0 + t0 + 2 * rg + i) * DM + gcol); ozr[i] = *(const u32x4*)(T.OZ + (row0 + t0 + 2 * rg + i) * DM + gcol); }
#pragma unroll
            for (int ten = 0; ten < 2; ++ten) {
                float w[5][8];
#pragma unroll
                for (int j = 0; j < 5; ++j) { const f32x4 wa = *(const ML_LAS f32x4*)(CONV + ten * 640 + j * 128 + 8 * dch), wb = *(const ML_LAS f32x4*)(CONV + ten * 640 + j * 128 + 8 * dch + 4);
                    w[j][0] = wa.x; w[j][1] = wa.y; w[j][2] = wa.z; w[j][3] = wa.w; w[j][4] = wb.x; w[j][5] = wb.y; w[j][6] = wb.z; w[j][7] = wb.w; }
                float o0[8], o1[8];
#pragma unroll
                for (int e = 0; e < 8; ++e) { float x[5];
#pragma unroll
                    for (int i = 0; i < 5; ++i) { const unsigned wd = raw[ten][i][e >> 1]; x[i] = (e & 1) ? bhi(wd) : blo(wd); }
                    o0[e] = silu(w[4][e] + w[0][e] * x[0] + w[1][e] * x[1] + w[2][e] * x[2] + w[3][e] * x[3]);
                    o1[e] = silu(w[4][e] + w[0][e] * x[1] + w[1][e] * x[2] + w[2][e] * x[3] + w[3][e] * x[4]); }
                if (ten == 0) {
                    *(ML_LAS u32x4*)(lds + O_Q + (2 * rg) * PQ + 16 * dch) = (u32x4){pk(o0[0], o0[1]), pk(o0[2], o0[3]), pk(o0[4], o0[5]), pk(o0[6], o0[7])};
                    *(ML_LAS u32x4*)(lds + O_Q + (2 * rg + 1) * PQ + 16 * dch) = (u32x4){pk(o1[0], o1[1]), pk(o1[2], o1[3]), pk(o1[4], o1[5]), pk(o1[6], o1[7])};
                } else {
#pragma unroll
                    for (int e = 0; e < 8; ++e) { o0[e] *= wsA; o1[e] *= wsB; }
                    *(ML_LAS u32x4*)(lds + O_KW + (2 * rg) * PQ + 16 * dch) = (u32x4){pk(o0[0], o0[1]), pk(o0[2], o0[3]), pk(o0[4], o0[5]), pk(o0[6], o0[7])};
                    *(ML_LAS u32x4*)(lds + O_KW + (2 * rg + 1) * PQ + 16 * dch) = (u32x4){pk(o1[0], o1[1]), pk(o1[2], o1[3]), pk(o1[4], o1[5]), pk(o1[6], o1[7])};
#pragma unroll
                    for (int e = 0; e < 8; ++e) *(ML_LAS unsigned*)(lds + O_KWT + (8 * dch + e) * PT + 4 * rg) = pk(o0[e], o1[e]);
                }
            }
#pragma unroll
            for (int e = 0; e < 8; ++e) { const unsigned w0 = vr[0][e >> 1], w1 = vr[1][e >> 1];
                *(ML_LAS unsigned*)(lds + O_VT + (8 * dch + e) * PT + 4 * rg) = (e & 1) ? ((w0 >> 16) | (w1 & 0xffff0000u)) : ((w0 & 0xffffu) | (w1 << 16)); }
        }
        {
            const int dj = wid & 3, vb = 64 * (wid >> 2);
#pragma unroll
            for (int r = 0; r < 16; ++r) { C0[r] *= decay; C1[r] *= decay; }
#pragma unroll
            for (int g = 0; g < 4; ++g) { const int d0 = 32 * dj + 8 * g + 4 * hi;
                *(ML_LAS u32x2*)(lds + O_CDT + (vb + r32) * PQ + d0 * 2) = (u32x2){pk(C0[4 * g], C0[4 * g + 1]), pk(C0[4 * g + 2], C0[4 * g + 3])};
                *(ML_LAS u32x2*)(lds + O_CDT + (vb + 32 + r32) * PQ + d0 * 2) = (u32x2){pk(C1[4 * g], C1[4 * g + 1]), pk(C1[4 * g + 2], C1[4 * g + 3])}; }
            if (tid < 128) { nst *= decay; ND[tid] = nst; }
        }
        __syncthreads();
        {
            const int ti = wid >> 1, c16 = lane & 15, q4 = lane >> 4, t = 16 * ti + c16;
            f32x4 acc[2] = {(f32x4){0.f, 0.f, 0.f, 0.f}, (f32x4){0.f, 0.f, 0.f, 0.f}};
#pragma unroll
            for (int kk = 0; kk < 4; ++kk) { const bf16x8 bq = *(const ML_LAS bf16x8*)(lds + O_Q + t * PQ + (32 * kk + 8 * q4) * 2);
#pragma unroll
                for (int j = 0; j < 2; ++j) { const int si = 2 * (wid & 1) + j; const bf16x8 ak = *(const ML_LAS bf16x8*)(lds + O_KW + (16 * si + c16) * PQ + (32 * kk + 8 * q4) * 2);
                    acc[j] = __builtin_amdgcn_mfma_f32_16x16x32_bf16(ak, bq, acc[j], 0, 0, 0); } }
            float dsum = 0.f;
#pragma unroll
            for (int j = 0; j < 2; ++j) { const int s0 = 16 * (2 * (wid & 1) + j) + 4 * q4; float x[4];
#pragma unroll
                for (int e = 0; e < 4; ++e) { x[e] = (s0 + e <= t) ? acc[j][e] : 0.f; dsum += x[e]; }
                *(ML_LAS u32x2*)(lds + O_S + t * PT + s0 * 2) = (u32x2){pk(x[0], x[1]), pk(x[2], x[3])}; }
            dsum += __shfl_xor(dsum, 16); dsum += __shfl_xor(dsum, 32);
            if (q4 == 0) DI[(wid & 1) * 64 + t] = dsum;
            const u32x4 qa = *(const ML_LAS u32x4*)(lds + O_Q + lane * PQ + 32 * wid), qb = *(const ML_LAS u32x4*)(lds + O_Q + lane * PQ + 32 * wid + 16);
            float p = 0.f;
#pragma unroll
            for (int e = 0; e < 4; ++e) { const f32x4 n0 = *(const ML_LAS f32x4*)(ND + 16 * wid + 4 * e); const unsigned w0 = (e < 2) ? qa[2 * e] : qb[2 * e - 4], w1 = (e < 2) ? qa[2 * e + 1] : qb[2 * e - 3];
                p += blo(w0) * n0.x + bhi(w0) * n0.y + blo(w1) * n0.z + bhi(w1) * n0.w; }
            DP[wid * 64 + lane] = p;
        }
        __syncthreads();
        f32x16 acc;
        float mean_s1, mean_s2;
        const int ti = wid & 1, vi = wid >> 1, tl = 32 * ti + r32;
        {
#pragma unroll
            for (int r = 0; r < 16; ++r) acc[r] = 0.f;
#pragma unroll
            for (int ks = 0; ks < 4; ++ks) { const bf16x8 av = *(const ML_LAS bf16x8*)(lds + O_VT + (32 * vi + r32) * PT + (16 * ks + 8 * hi) * 2), bs = *(const ML_LAS bf16x8*)(lds + O_S + tl * PT + (16 * ks + 8 * hi) * 2);
                acc = __builtin_amdgcn_mfma_f32_32x32x16_bf16(av, bs, acc, 0, 0, 0); }
#pragma unroll
            for (int ks = 0; ks < 8; ++ks) { const bf16x8 ac = *(const ML_LAS bf16x8*)(lds + O_CDT + (32 * vi + r32) * PQ + (16 * ks + 8 * hi) * 2), bq = *(const ML_LAS bf16x8*)(lds + O_Q + tl * PQ + (16 * ks + 8 * hi) * 2);
                acc = __builtin_amdgcn_mfma_f32_32x32x16_bf16(ac, bq, acc, 0, 0, 0); }
            const int dj = wid & 3, vb = 64 * (wid >> 2);
#pragma unroll
            for (int ks = 0; ks < 4; ++ks) { const bf16x8 ak = *(const ML_LAS bf16x8*)(lds + O_KWT + (32 * dj + r32) * PT + (16 * ks + 8 * hi) * 2);
                const bf16x8 b0 = *(const ML_LAS bf16x8*)(lds + O_VT + (vb + r32) * PT + (16 * ks + 8 * hi) * 2), b1 = *(const ML_LAS bf16x8*)(lds + O_VT + (vb + 32 + r32) * PT + (16 * ks + 8 * hi) * 2);
                C0 = __builtin_amdgcn_mfma_f32_32x32x16_bf16(ak, b0, C0, 0, 0, 0); C1 = __builtin_amdgcn_mfma_f32_32x32x16_bf16(ak, b1, C1, 0, 0, 0); }
            if (tid < 128) { float sk = 0.f;
#pragma unroll
                for (int i = 0; i < 8; ++i) { const u32x4 kw = *(const ML_LAS u32x4*)(lds + O_KWT + tid * PT + 16 * i);
#pragma unroll
                    for (int e = 0; e < 4; ++e) sk += blo(kw[e]) + bhi(kw[e]); }
                nst += sk; }
            float den = DI[tl] + DI[64 + tl];
#pragma unroll
            for (int sg = 0; sg < 8; ++sg) den += DP[sg * 64 + tl];
            const float rden = 1.0f / fmaxf(fabsf(den), CL[tl]);
            float s1 = 0.f, s2 = 0.f;
#pragma unroll
            for (int r = 0; r < 16; ++r) { acc[r] *= rden; s1 += acc[r]; s2 += acc[r] * acc[r]; }
            s1 += __shfl_xor(s1, 32); s2 += __shfl_xor(s2, 32);
            if (hi == 0) { LNP[(vi * 64 + tl) * 2] = s1; LNP[(vi * 64 + tl) * 2 + 1] = s2; }
        }
        __syncthreads();
        {
            mean_s1 = 0.f; mean_s2 = 0.f;
#pragma unroll
            for (int j = 0; j < 4; ++j) { mean_s1 += LNP[(j * 64 + tl) * 2]; mean_s2 += LNP[(j * 64 + tl) * 2 + 1]; }
            const float mu = mean_s1 * (1.f / 128.f), var = mean_s2 * (1.f / 128.f) - mu * mu, rstd = 1.0f / sqrtf(fmaxf(var, 0.f) + 1e-5f);
#pragma unroll
            for (int g = 0; g < 4; ++g) { const int v0 = 32 * vi + 8 * g + 4 * hi;
                *(ML_LAS u32x2*)(lds + O_HN + tl * PQ + v0 * 2) = (u32x2){pk((acc[4 * g] - mu) * rstd, (acc[4 * g + 1] - mu) * rstd), pk((acc[4 * g + 2] - mu) * rstd, (acc[4 * g + 3] - mu) * rstd)}; }
        }
        __syncthreads();
#pragma unroll
        for (int i = 0; i < 2; ++i) { const u32x4 hn = *(const ML_LAS u32x4*)(lds + O_HN + (2 * rg + i) * PQ + 16 * dch); u32x4 ov;
#pragma unroll
            for (int e = 0; e < 4; ++e) ov[e] = pk(blo(hn[e]) * mhw[2 * e] * blo(ozr[i][e]), bhi(hn[e]) * mhw[2 * e + 1] * bhi(ozr[i][e]));
            if (!dry) *(u32x4*)(T.OZ + (row0 + t0 + 2 * rg + i) * DM + (size_t)h * 128 + 8 * dch) = ov; }
    }
    __syncthreads();
}
}

constexpr int NWAVES = 8;
constexpr int BATCH = 16, SEQ = 2048, DM = 1024, M = BATCH * SEQ, DIN = 11280, NH = 8;
constexpr int N1 = 9216;
constexpr float C2 = 0.125f * 1.4426950408889634f;
constexpr float LOG2E = 1.4426950408889634f;
constexpr float LAMBDA_INIT = 0.2f;
constexpr size_t MiB = 1u << 20;
constexpr size_t WS_CTL = 0, CTL_ZERO_BYTES = 1 * MiB;
constexpr size_t WS_TAB = 1 * MiB;
constexpr size_t WS_G = 2 * MiB;
constexpr size_t WS_W1 = 4 * MiB;
constexpr size_t WS_WG = 22 * MiB;
constexpr size_t WS_WP = 26 * MiB;
constexpr size_t WS_WO = 30 * MiB;
constexpr size_t WS_XN = 32 * MiB;
constexpr size_t WS_BQ = 96 * MiB, BUF = 64 * MiB;
constexpr size_t WS_BK = WS_BQ + BUF, WS_BV = WS_BQ + 2 * BUF, WS_BZ = WS_BQ + 3 * BUF, WS_MQ = WS_BQ + 4 * BUF, WS_MK = WS_BQ + 5 * BUF;
constexpr size_t WS_SP = 480 * MiB;
constexpr size_t WS_END = 512 * MiB;

constexpr int LDS_BYTES = 163840, MISC_OFF = LDS_BYTES - 256;
constexpr int CW_BAR = 4096;

#define GAS __attribute__((address_space(1)))
#define LAS __attribute__((address_space(3)))
typedef unsigned short bf16;
typedef unsigned v4u __attribute__((ext_vector_type(4)));
typedef float f32x4 __attribute__((ext_vector_type(4)));
#define LDS_WAIT() asm volatile("s_waitcnt lgkmcnt(0)" ::: "memory")
#define VM_WAIT() asm volatile("s_waitcnt vmcnt(0)" ::: "memory")
__device__ __forceinline__ unsigned f2bf(float f) { unsigned u = __builtin_bit_cast(unsigned, f); return (u + 0x7fffu + ((u >> 16) & 1u)) >> 16; }
__device__ __forceinline__ unsigned pk2(float lo, float hi) { return f2bf(lo) | (f2bf(hi) << 16); }
__device__ __forceinline__ float bf2f(bf16 v) { return __uint_as_float((unsigned)v << 16); }
__device__ __forceinline__ float wave_sum(float v) {
#pragma unroll
    for (int o = 1; o < 64; o <<= 1) v += __shfl_xor(v, o);
    return v;
}

typedef GAS unsigned gu32;
#define RLX_AGENT __ATOMIC_RELAXED, __HIP_MEMORY_SCOPE_AGENT
#define XB_TMO      128
#define XB_XCNT(j)  (256  + 64 * (j))
#define XB_XSUB(j)  (1280 + 64 * (j))
#define XB_XGEN(j)  (2304 + 64 * (j))
#define XB_TOP      3328
#define XB_TOPGEN   3392
#define XCD_BAR_WORDS 3456
#define XB_SPIN_CAP (1u << 18)

__device__ __forceinline__ unsigned xb_ld(unsigned* p)              { return __hip_atomic_load(p, __ATOMIC_RELAXED, __HIP_MEMORY_SCOPE_AGENT); }
__device__ __forceinline__ unsigned xb_add(unsigned* p, unsigned v) { return __hip_atomic_fetch_add(p, v, __ATOMIC_RELAXED, __HIP_MEMORY_SCOPE_AGENT); }
__device__ __forceinline__ unsigned xb_xcc_id() { return (unsigned)__builtin_amdgcn_s_getreg((3 << 11) | 20) & 0xFu; }
#define XB_SPIN(cond, bar) do { unsigned _sp = 0; while (cond) { __builtin_amdgcn_s_sleep(1); \
    if ((++_sp & 255u) == 0u) { if (xb_ld(&(bar)[XB_TMO])) break; if (_sp > XB_SPIN_CAP) { atomicAdd(&(bar)[XB_TMO], 1u); break; } } } } while (0)

struct XcdBarrier {
    unsigned* bar; unsigned x;
    volatile LAS unsigned* st;
};

__device__ __forceinline__ XcdBarrier xcd_barrier_post(unsigned* bar, volatile LAS unsigned* st) {
    XcdBarrier b; b.bar = bar; b.x = xb_xcc_id(); b.st = st;
    if (threadIdx.x == 0) (void)xb_add(&bar[XB_XCNT(b.x)], 1u);
    return b;
}
__device__ __forceinline__ void xcd_barrier_complete(unsigned* bar, unsigned x, unsigned& nloc, unsigned& nx) {
    const unsigned G = gridDim.x * gridDim.y * gridDim.z;
    unsigned sum, cnt, mine, sp = 0u;
    for (;;) {
        sum = 0u; cnt = 0u; mine = 0u;
#pragma unroll
        for (unsigned j = 0; j < 16; ++j) { const unsigned c = xb_ld(&bar[XB_XCNT(j)]); sum += c; cnt += (c > 0u) ? 1u : 0u; mine = (j == x) ? c : mine; }
        if (sum == G) break;
        __builtin_amdgcn_s_sleep(1);
        if ((++sp & 255u) == 0u) { if (xb_ld(&bar[XB_TMO])) break; if (sp > XB_SPIN_CAP) { atomicAdd(&bar[XB_TMO], 1u); break; } }
    }
    nloc = mine > 0u ? mine : 1u; nx = cnt > 0u ? cnt : 1u;
}

__device__ __forceinline__ void xcd_barrier(const XcdBarrier& b) {
    asm volatile("s_waitcnt vmcnt(0)" ::: "memory");
    __syncthreads();
    if (threadIdx.x == 0) {
        unsigned* bar = b.bar;
        __builtin_amdgcn_s_waitcnt(0);
        unsigned nloc = b.st[0], nx = b.st[1];
        if (nloc == 0u) { xcd_barrier_complete(bar, b.x, nloc, nx); b.st[0] = nloc; b.st[1] = nx; }
        const unsigned old = xb_add(&bar[XB_XSUB(b.x)], 1u);
        const unsigned gen = old / nloc;
        if (old + 1u == (gen + 1u) * nloc) {
            __builtin_amdgcn_fence(__ATOMIC_RELEASE, "agent");
            asm volatile("s_waitcnt vmcnt(0)" ::: "memory");
            const unsigned og = xb_add(&bar[XB_TOP], 1u);
            const unsigned tg = og / nx;
            if (og + 1u == (tg + 1u) * nx) xb_add(&bar[XB_TOPGEN], 1u);
            else XB_SPIN(xb_ld(&bar[XB_TOPGEN]) == tg, bar);
            __builtin_amdgcn_fence(__ATOMIC_ACQUIRE, "agent");
            xb_add(&bar[XB_XGEN(b.x)], 1u);
            asm volatile("s_waitcnt vmcnt(0)" ::: "memory");
        } else {
            XB_SPIN(xb_ld(&bar[XB_XGEN(b.x)]) == gen, bar);
            __builtin_amdgcn_fence(__ATOMIC_ACQUIRE, "agent");
            asm volatile("s_waitcnt vmcnt(0)" ::: "memory");
        }
    }
    __syncthreads();
}


struct Frame {
    LAS unsigned char* lds;
    int tid, lane, wave, vcu, G;
    const float *x, *norm_w, *w_in, *lam, *subln_w, *rel_bias, *conv_w, *conv_b, *b_if, *mh_w, *b_gate, *w_pa, *w_pm, *w_out, *norm_final;
    float* out; unsigned char* ws;
};

__device__ __forceinline__ void tr_item(const float* W, int ldw, int src_n0, bf16* WT, int K, int dst_n0, int k0, LAS float* scr, int lane) {
    float tv[32];
#pragma unroll
    for (int i = 0; i < 32; ++i) tv[i] = W[(size_t)(k0 + 2 * i + (lane >> 5)) * ldw + src_n0 + (lane & 31)];
#pragma unroll
    for (int i = 0; i < 32; ++i) scr[(2 * i + (lane >> 5)) * 33 + (lane & 31)] = tv[i];
    LDS_WAIT(); asm volatile("" ::: "memory");
    const int c = lane & 7;
#pragma unroll
    for (int j = 0; j < 4; ++j) { const int n = (lane >> 3) + 8 * j; const LAS float* s = scr + (8 * c) * 33 + n;
        v4u o; o.x = pk2(s[0 * 33], s[1 * 33]); o.y = pk2(s[2 * 33], s[3 * 33]); o.z = pk2(s[4 * 33], s[5 * 33]); o.w = pk2(s[6 * 33], s[7 * 33]);
        *(GAS v4u*)(WT + (size_t)(dst_n0 + n) * K + k0 + 8 * c) = o; }
    LDS_WAIT(); asm volatile("" ::: "memory");
}
__device__ __forceinline__ int w1_src_col(int n0) {
    if (n0 < 7168) return n0;
    const int t = (n0 - 7168) >> 8, w = (n0 - 7168) & 255;
    return (w < 128) ? 7168 + t * 128 + w : 8192 + t * 128 + (w - 128);
}
__device__ __forceinline__ float log_sigmoid_f(float x) { return fminf(x, 0.f) - log1pf(expf(-fabsf(x))); }
__device__ __forceinline__ int rel_bucket(int rel) {
    const int n = rel < 0 ? -rel : rel; int b = rel > 0 ? 16 : 0;
    int large = 8 + (n >= 12) + (n >= 16) + (n >= 23) + (n >= 32) + (n >= 46) + (n >= 64) + (n >= 91);
    return b + (n < 8 ? n : large);
}

__device__ __forceinline__ void p0_prologue(Frame& F) {
    const float* wpa = F.w_pa; const float* wpm = F.w_pm; const float* wout = F.w_out;
    asm volatile("" : "+s"(wpa), "+s"(wpm), "+s"(wout));
    const int gw = F.vcu * NWAVES + F.wave, NGW = F.G * NWAVES;
    if (blockIdx.x == 0) {
        float* tab = (float*)(F.ws + WS_TAB);
        for (int i = F.tid; i < 8 * 256; i += NWAVES * 64) { const int h = i >> 8, delta = (i & 255) - 192;
            tab[i] = (F.rel_bias[rel_bucket(delta) * 8 + h] - F.rel_bias[15 * 8 + h]) * LOG2E; }
        if (F.wave == 0) { const float a = wave_sum(F.lam[F.lane] * F.lam[64 + F.lane]), b = wave_sum(F.lam[128 + F.lane] * F.lam[192 + F.lane]);
            if (F.lane == 0) tab[2048] = expf(a) - expf(b) + LAMBDA_INIT; }
    }
    { LAS float* scr = (LAS float*)(F.lds + F.wave * 16384);
      constexpr int I_W1 = 16 * (N1 / 32), I_WG = 16 * (2048 / 32), I_P = 16 * (1024 / 32);
      constexpr int NITEMS = I_W1 + I_WG + 3 * I_P;
      for (int it = gw; it < NITEMS; it += NGW) {
          int r = it; const float* W; int ldw, src, dst, kb; bf16* WT;
          if (r < I_W1) { kb = r / (N1 / 32); const int nb = r % (N1 / 32); W = F.w_in; ldw = DIN; src = w1_src_col(nb * 32); WT = (bf16*)(F.ws + WS_W1); dst = nb * 32; }
          else if ((r -= I_W1) < I_WG) { kb = r / 64; const int nb = r % 64; W = F.w_in; ldw = DIN; src = 9232 + nb * 32; WT = (bf16*)(F.ws + WS_WG); dst = nb * 32; }
          else { r -= I_WG; const int wsel = r / I_P; r -= wsel * I_P; kb = r / 32; const int nb = r % 32; ldw = 1024; src = nb * 32;
                 W = (wsel == 0) ? wpa : (wsel == 1) ? wpm : wout; WT = (bf16*)(F.ws + (wsel == 2 ? WS_WO : WS_WP)); dst = (wsel == 1 ? 1024 : 0) + nb * 32; }
          tr_item(W, ldw, src, WT, 1024, dst, kb * 64, scr, F.lane);
      } }
    __syncthreads();
    LAS float* T = (LAS float*)F.lds;
    for (int i = F.tid; i < 1024 * 4; i += NWAVES * 64) { const int k = i >> 2, q = i & 3; const int p = ((k & 3) + 4 * (k >> 8)) * 64 + ((k >> 2) & 63);
        *(LAS f32x4*)(T + p * 20 + q * 4) = *(const f32x4*)(F.w_in + (size_t)k * DIN + 9216 + q * 4); }
    __syncthreads();
    f32x4 nw[4];
#pragma unroll
    for (int j = 0; j < 4; ++j) nw[j] = *(const f32x4*)(F.norm_w + 4 * F.lane + 256 * j);
    bf16* XN = (bf16*)(F.ws + WS_XN); float* Gt = (float*)(F.ws + WS_G);
    const int gcol = ((F.lane >> 5) & 1) * 8 + ((F.lane >> 4) & 1) * 4 + ((F.lane >> 3) & 1) * 2 + ((F.lane >> 2) & 1);
    const float bi = F.b_if[gcol];
    f32x4 vn[4];
    if (gw < M) {
#pragma unroll
        for (int j = 0; j < 4; ++j) vn[j] = ((const GAS f32x4*)(F.x + (size_t)gw * DM) + F.lane)[64 * j]; }
    for (int m = gw; m < M; m += NGW) {
        f32x4 v[4]; float ss = 0.f;
#pragma unroll
        for (int j = 0; j < 4; ++j) { v[j] = vn[j]; ss += (v[j].x * v[j].x + v[j].y * v[j].y) + (v[j].z * v[j].z + v[j].w * v[j].w); }
        if (m + NGW < M) {
#pragma unroll
            for (int j = 0; j < 4; ++j) vn[j] = ((const GAS f32x4*)(F.x + (size_t)(m + NGW) * DM) + F.lane)[64 * j]; }
        const float r = 1.0f / sqrtf(wave_sum(ss) * (1.f / DM) + 1e-6f);
        float s[16];
#pragma unroll
        for (int n = 0; n < 16; ++n) s[n] = 0.f;
        GAS unsigned long long* o8 = (GAS unsigned long long*)(XN + (size_t)m * DM) + F.lane;
#pragma unroll
        for (int j = 0; j < 4; ++j) { v[j] = v[j] * r * nw[j];
            o8[64 * j] = (unsigned long long)pk2(v[j].x, v[j].y) | ((unsigned long long)pk2(v[j].z, v[j].w) << 32);
#pragma unroll
            for (int i = 0; i < 4; ++i) { const LAS float* tp = T + ((i + 4 * j) * 64 + F.lane) * 20; const float xv = v[j][i];
#pragma unroll
                for (int q = 0; q < 4; ++q) { const f32x4 w = *(const LAS f32x4*)(tp + 4 * q); s[4 * q] += xv * w.x; s[4 * q + 1] += xv * w.y; s[4 * q + 2] += xv * w.z; s[4 * q + 3] += xv * w.w; }
                asm volatile("" ::: "memory"); } }
        float t8[8], t4[4], t2[2], t1;
        { const bool up = (F.lane & 32) != 0;
#pragma unroll
          for (int j = 0; j < 8; ++j) { const float snd = up ? s[j] : s[j + 8], kp = up ? s[j + 8] : s[j]; t8[j] = kp + __shfl_xor(snd, 32); } }
        { const bool up = (F.lane & 16) != 0;
#pragma unroll
          for (int j = 0; j < 4; ++j) { const float snd = up ? t8[j] : t8[j + 4], kp = up ? t8[j + 4] : t8[j]; t4[j] = kp + __shfl_xor(snd, 16); } }
        { const bool up = (F.lane & 8) != 0;
#pragma unroll
          for (int j = 0; j < 2; ++j) { const float snd = up ? t4[j] : t4[j + 2], kp = up ? t4[j + 2] : t4[j]; t2[j] = kp + __shfl_xor(snd, 8); } }
        { const bool up = (F.lane & 4) != 0; const float snd = up ? t2[0] : t2[1], kp = up ? t2[1] : t2[0]; t1 = kp + __shfl_xor(snd, 4); }
        t1 += __shfl_xor(t1, 2); t1 += __shfl_xor(t1, 1);
        if ((F.lane & 3) == 0) { const float pre = t1 + bi; Gt[(size_t)m * 16 + gcol] = (gcol < 8) ? pre : log_sigmoid_f(pre); }
    }
}

__device__ __forceinline__ void p_final_norm(Frame& F) {
    const int gw = F.vcu * NWAVES + F.wave, NGW = F.G * NWAVES;
    f32x4 nw[4];
#pragma unroll
    for (int j = 0; j < 4; ++j) nw[j] = *(const f32x4*)(F.norm_final + 4 * F.lane + 256 * j);
    for (int m = gw; m < M; m += NGW) {
        GAS f32x4* xr = (GAS f32x4*)(F.out + (size_t)m * DM) + F.lane;
        f32x4 v[4]; float ss = 0.f;
#pragma unroll
        for (int j = 0; j < 4; ++j) { v[j] = xr[64 * j]; ss += (v[j].x * v[j].x + v[j].y * v[j].y) + (v[j].z * v[j].z + v[j].w * v[j].w); }
        const float r = 1.0f / sqrtf(wave_sum(ss) * (1.f / DM) + 1e-6f);
#pragma unroll
        for (int j = 0; j < 4; ++j) xr[64 * j] = v[j] * r * nw[j];
    }
}

struct Args { const float* in[15]; float* out; unsigned char* ws; int ph_lo, ph_hi; };
__global__ void __launch_bounds__(NWAVES * 64, 2) skel_fwd(Args args) {
    extern __shared__ __attribute__((aligned(16))) unsigned char lds[];
    Frame F;
    F.lds = (LAS unsigned char*)lds;
    F.tid = threadIdx.x; F.lane = F.tid & 63; F.wave = __builtin_amdgcn_readfirstlane(F.tid >> 6);
    F.G = gridDim.x; { const int bx = blockIdx.x; F.vcu = (F.G % 8 == 0) ? (bx % 8) * (F.G / 8) + bx / 8 : bx; }
    F.x = args.in[0]; F.norm_w = args.in[1]; F.w_in = args.in[2]; F.lam = args.in[3]; F.subln_w = args.in[4]; F.rel_bias = args.in[5]; F.conv_w = args.in[6]; F.conv_b = args.in[7];
    F.b_if = args.in[8]; F.mh_w = args.in[9]; F.b_gate = args.in[10]; F.w_pa = args.in[11]; F.w_pm = args.in[12]; F.w_out = args.in[13]; F.norm_final = args.in[14];
    F.out = args.out; F.ws = args.ws;
    unsigned char* ws = args.ws;
    const int lo = args.ph_lo, hi = args.ph_hi;
#define IN(k) (lo <= (k) && (k) < hi)
    volatile LAS unsigned* MISC = (volatile LAS unsigned*)(F.lds + MISC_OFF);
    if (F.tid < 64) MISC[F.tid] = 0u;
    __syncthreads();
    XcdBarrier bar; bar.bar = (unsigned*)(ws + WS_CTL) + CW_BAR; bar.x = 0; bar.st = nullptr;
    if (hi - lo > 1) bar = xcd_barrier_post((unsigned*)(ws + WS_CTL) + CW_BAR, MISC + 8);
    int n_sync = 0;
#define GRID_SYNC(cond) do { if (cond) { if (USE_CG_SYNC || (CG_FIRST && n_sync == 0)) { cooperative_groups::this_grid().sync(); } else { xcd_barrier(bar); } ++n_sync; } } while (0)
    if (IN(0)) for (int it = (REP_PHASE == 0 ? 0 : 1); it < 2; ++it) p0_prologue(F);
    GRID_SYNC(IN(0) && IN(1));
    if (IN(1)) {
        pg8::Gemm g{(const bf16*)(ws + WS_XN), nullptr, nullptr, (const bf16*)(ws + WS_W1), M, N1, DM}; pg8::RepOrder S; S.init(M, N1, F.G, (int)blockIdx.x, REP_PHASE == 1 ? 2 : 1);
        pg8::EpiP1 E{(bf16*)(ws + WS_BQ), BUF / 2, (bf16*)F.out, (bf16*)F.out + (size_t)M * DM, C2};
        pg8::gemm_phase<pg8::EpiP1, pg8::RepOrder, true, true>(F.lds, g, S, E);
    }
    GRID_SYNC(IN(1) && IN(2));
    if (IN(2)) {
        const attn_body::AttnTensors AT{(const attn_body::bf16*)(ws + WS_BQ), (const attn_body::bf16*)(ws + WS_BK), (const attn_body::bf16*)(ws + WS_BV), (const attn_body::bf16*)(ws + WS_BZ),
                                        (attn_body::bf16*)(ws + WS_BQ), (float*)(ws + WS_SP), (const float*)(ws + WS_TAB), F.subln_w};
        const mlstm_body::Tensors MT{(const bf16*)(ws + WS_MQ), (const bf16*)(ws + WS_MK), (const bf16*)F.out, (const float*)(ws + WS_G), F.conv_w, F.conv_b, F.mh_w, (bf16*)F.out + (size_t)M * DM};
        if (F.G == 256) {
            const int bh = F.vcu >> 1;
            if ((F.vcu & 1) == 0) { for (int it = (REP_PHASE == 3 ? 0 : 1); it < 2; ++it) mlstm_body::mlstm_seq(F.lds, MT, bh, it == 0); }
            for (int it = (REP_PHASE == 2 ? 0 : 1); it < 2; ++it) attn_body::attn_phase<8>((char*)lds, AT, bh, (F.vcu & 1) ? QMASK_HEAVY : QMASK_LIGHT, it == 0);
        } else {
            for (int bh = F.vcu; bh < BATCH * NH; bh += F.G) mlstm_body::mlstm_seq(F.lds, MT, bh, false);
            for (int bh = F.vcu; bh < BATCH * NH; bh += F.G) attn_body::attn_phase<8>((char*)lds, AT, bh, 0xffu, false);
        }
    }
    GRID_SYNC(IN(3) && IN(4));
    if (IN(4)) {
        pg8::Gemm g{(const bf16*)(ws + WS_XN), (const bf16*)(ws + WS_BQ), (const bf16*)F.out + (size_t)M * DM, (const bf16*)(ws + WS_WG), M, DM, DM}; pg8::QuadOrder S; S.init(M, DM, F.G, (int)blockIdx.x);
        pg8::EpiGM E{(bf16*)(ws + WS_BK), (bf16*)(ws + WS_BV), (bf16*)(ws + WS_BZ), (bf16*)(ws + WS_MQ), F.b_gate};
        for (int it = (REP_PHASE == 4 ? 0 : 1); it < 2; ++it) pg8::gemm_phase<pg8::EpiGM, pg8::QuadOrder, true, true>(F.lds, g, S, E);
    }
    GRID_SYNC(IN(4) && IN(6));
    if (IN(6)) {
        pg8::Gemm g{(const bf16*)(ws + WS_MQ), nullptr, nullptr, (const bf16*)(ws + WS_WO), M, DM, DM}; pg8::StaticOrder S; S.init(M, DM, F.G, (int)blockIdx.x);
        pg8::EpiRes E{F.x, F.out};
        for (int it = (REP_PHASE == 6 ? 0 : 1); it < 2; ++it) pg8::gemm_phase<pg8::EpiRes, pg8::StaticOrder, true, true>(F.lds, g, S, E);
    }
    GRID_SYNC(IN(6) && IN(7));
    if (IN(7)) p_final_norm(F);
#undef IN
}

__global__ void __launch_bounds__(256) naive_attn(const bf16* Q, const bf16* K, const bf16* V, const bf16* SZ, const float* tab, const float* subln_w, bf16* Y) {
    __shared__ float Ks[64][64]; __shared__ float Vs[64][128]; __shared__ float red[4][64]; __shared__ float tabs[256];
    const int tid = threadIdx.x, qi = tid & 63, vq = tid >> 6;
    const int c = blockIdx.x & 31, bh = blockIdx.x >> 5, b = bh >> 3, h = bh & 7;
    const float lamv = tab[2048];
    tabs[tid] = tab[h * 256 + tid];
    const size_t qrow = (size_t)b * SEQ + 64 * c + qi;
    float o0[32], attn[32];
    for (int p = 0; p < 2; ++p) {
        float q[64];
#pragma unroll
        for (int d = 0; d < 64; ++d) q[d] = bf2f(Q[qrow * DM + h * 128 + p * 64 + d]);
        float mx = -1e30f, l = 0.f, o[32];
#pragma unroll
        for (int i = 0; i < 32; ++i) o[i] = 0.f;
        for (int j = 0; j <= c; ++j) {
            __syncthreads();
            for (int e = tid; e < 64 * 64; e += 256) { const int s = e >> 6, d = e & 63; Ks[s][d] = bf2f(K[((size_t)b * SEQ + 64 * j + s) * DM + h * 128 + p * 64 + d]); }
            for (int e = tid; e < 64 * 128; e += 256) { const int s = e >> 7, d = e & 127; Vs[s][d] = bf2f(V[((size_t)b * SEQ + 64 * j + s) * DM + h * 128 + d]); }
            __syncthreads();
            for (int s = 0; s < 64; ++s) {
                float dot = 0.f;
#pragma unroll
                for (int d = 0; d < 64; ++d) dot += q[d] * Ks[s][d];
                const int idx = (64 * j + s) - (64 * c + qi) + 192;
                const float logit = dot + (idx >= 0 ? tabs[idx] : 0.f);
                const float mn = fmaxf(mx, logit), sc = exp2f(mx - mn), pr = exp2f(logit - mn);
                l = l * sc + pr; mx = mn;
#pragma unroll
                for (int i = 0; i < 32; ++i) o[i] = o[i] * sc + pr * Vs[s][32 * vq + i];
            }
        }
        const float il = 1.0f / l;
#pragma unroll
        for (int i = 0; i < 32; ++i) { if (p == 0) o0[i] = o[i] * il; else attn[i] = o0[i] - lamv * (o[i] * il); }
    }
    float ss = 0.f;
#pragma unroll
    for (int i = 0; i < 32; ++i) ss += attn[i] * attn[i];
    red[vq][qi] = ss; __syncthreads();
    const float r = 1.0f / sqrtf((red[0][qi] + red[1][qi] + red[2][qi] + red[3][qi]) * (1.f / 128.f) + 1e-5f);
#pragma unroll
    for (int i = 0; i < 32; ++i) { const size_t a = qrow * DM + h * 128 + 32 * vq + i;
        Y[a] = (bf16)f2bf(attn[i] * r * subln_w[32 * vq + i] * (1.0f - LAMBDA_INIT) * bf2f(SZ[a])); }
}

__global__ void __launch_bounds__(256) naive_mlstm(const bf16* MQ, const bf16* MK, const bf16* MV, const float* G, const float* conv_w, const float* conv_b, const float* mh_w, bf16* OZ) {
    __shared__ float qs[128], ks[128], vs[128], part[2][128], red[4][4];
    const int tid = threadIdx.x, bh = blockIdx.x, b = bh >> 3, h = bh & 7, ch = tid & 127, isk = tid >> 7, lane = tid & 63, wave = tid >> 6;
    const bf16* src = isk ? MK : MQ;
    const float w0 = conv_w[(isk * 4 + 0) * 1024 + h * 128 + ch], w1 = conv_w[(isk * 4 + 1) * 1024 + h * 128 + ch], w2 = conv_w[(isk * 4 + 2) * 1024 + h * 128 + ch], w3 = conv_w[(isk * 4 + 3) * 1024 + h * 128 + ch];
    const float cb = conv_b[isk * 1024 + h * 128 + ch], mw = mh_w[h * 128 + ch];
    float h1 = 0.f, h2 = 0.f, h3 = 0.f, C[64], nst = 0.f;
#pragma unroll
    for (int j = 0; j < 64; ++j) C[j] = 0.f;
    for (int t = 0; t < SEQ; ++t) {
        const size_t row = (size_t)b * SEQ + t;
        const float raw = bf2f(src[row * DM + h * 128 + ch]);
        float cv = cb + w0 * h3 + w1 * h2 + w2 * h1 + w3 * raw; h3 = h2; h2 = h1; h1 = raw;
        cv = cv / (1.0f + expf(-cv));
        if (isk) ks[ch] = cv * 0.08838834764831845f; else { qs[ch] = cv; vs[ch] = bf2f(MV[row * DM + h * 128 + ch]); }
        __syncthreads();
        const float f = expf(G[row * 16 + 8 + h]), ii = expf(G[row * 16 + h]);
        const float vv = vs[ch]; float pn = 0.f;
#pragma unroll
        for (int j = 0; j < 64; ++j) { const int d = isk * 64 + j; C[j] = f * C[j] + ii * ks[d] * vv; pn += qs[d] * C[j]; }
        part[isk][ch] = pn;
        float dp = 0.f;
        if (!isk) { nst = f * nst + ii * ks[ch]; dp = qs[ch] * nst; }
        dp = wave_sum(dp); if (lane == 0) red[0][wave] = dp;
        __syncthreads();
        float hv = 0.f;
        if (!isk) { const float num = part[0][ch] + part[1][ch], den = red[0][0] + red[0][1]; hv = num / fmaxf(fabsf(den), 1.0f); }
        const float s1 = wave_sum(hv), s2 = wave_sum(hv * hv);
        if (lane == 0) { red[1][wave] = s1; red[2][wave] = s2; }
        __syncthreads();
        if (!isk) { const float mu = (red[1][0] + red[1][1]) * (1.f / 128.f), var = (red[2][0] + red[2][1]) * (1.f / 128.f) - mu * mu;
            const size_t a = row * DM + h * 128 + ch;
            OZ[a] = (bf16)f2bf((hv - mu) / sqrtf(var + 1e-5f) * mw * bf2f(OZ[a])); }
    }
}


__device__ __forceinline__ float dot_bf(const bf16* a, const bf16* b, int n) { float s = 0.f; for (int i = 0; i < n; ++i) s += bf2f(a[i]) * bf2f(b[i]); return s; }
__device__ __forceinline__ float sigm(float x) { return 1.0f / (1.0f + expf(-x)); }
__device__ __forceinline__ bool bad(float got, float ref) { return !(fabsf(got - ref) <= 0.03f * fabsf(ref) + 0.03f); }
__global__ void __launch_bounds__(256) chk_kernel(int which, Args args) {
    unsigned char* ws = args.ws; unsigned* fail = (unsigned*)(ws + WS_CTL) + 1024;
    const unsigned sidx = blockIdx.x * 256 + threadIdx.x;
    unsigned hsh = sidx * 2654435761u + 12345u; hsh ^= hsh >> 15; hsh *= 2246822519u; hsh ^= hsh >> 13;
    int row = hsh % M; int col = (hsh >> 15) % 1024;
    if (sidx < 4096) { row = (sidx & 1) ? M - 1 - (int)(sidx >> 1) % 512 : (int)(sidx >> 1) % 512; col = (sidx * 7) % 1024; }
    const bf16* XN = (const bf16*)(ws + WS_XN); const bf16* W1 = (const bf16*)(ws + WS_W1);
    bool f = false;
    if (which == 0) {
        const float* x = args.in[0]; float ss = 0.f; for (int k = 0; k < 1024; ++k) ss += x[(size_t)row * 1024 + k] * x[(size_t)row * 1024 + k];
        const float r = 1.0f / sqrtf(ss / 1024.f + 1e-6f); f = bad(bf2f(XN[(size_t)row * 1024 + col]), x[(size_t)row * 1024 + col] * r * args.in[1][col]);
        const int n = hsh % N1, k = col; const int n0 = n & ~31; const int src = w1_src_col(n0) + (n & 31);
        f = f || bad(bf2f(W1[(size_t)n * 1024 + k]), args.in[2][(size_t)k * DIN + src]);
        const bf16* WG = (const bf16*)(ws + WS_WG); const int ng = hsh % 2048; f = f || bad(bf2f(WG[(size_t)ng * 1024 + k]), args.in[2][(size_t)k * DIN + 9232 + ng]);
        const bf16* WP = (const bf16*)(ws + WS_WP); const int np = hsh % 1024; f = f || bad(bf2f(WP[(size_t)np * 1024 + k]), args.in[11][(size_t)k * 1024 + np]) || bad(bf2f(WP[(size_t)(1024 + np) * 1024 + k]), args.in[12][(size_t)k * 1024 + np]);
        const bf16* WO = (const bf16*)(ws + WS_WO); f = f || bad(bf2f(WO[(size_t)np * 1024 + k]), args.in[13][(size_t)k * 1024 + np]);
        if (f) atomicOr(fail + 0, 1u);
        const int gi = col & 15; float s = 0.f; const float* x2 = args.in[0] + (size_t)row * 1024;
        for (int k2 = 0; k2 < 1024; ++k2) s += x2[k2] * r * args.in[1][k2] * args.in[2][(size_t)k2 * DIN + 9216 + gi];
        s += args.in[8][gi]; if (gi >= 8) s = -log1pf(expf(-s));
        if (bad(((const float*)(ws + WS_G))[(size_t)row * 16 + gi], s)) atomicOr(fail + 1, 1u);
    } else if (which == 1) {
        const int g = (hsh >> 8) % 8; const bf16* xr = XN + (size_t)row * 1024;
        if (g < 7) { const bf16* buf = (g < 6) ? (const bf16*)(ws + WS_BQ) + (size_t)g * (BUF / 2) : (const bf16*)args.out;
            float d = dot_bf(xr, W1 + (size_t)(g * 1024 + col) * 1024, 1024); if (g == 0) d *= C2; if (g == 3) d = d * sigm(d);
            if (bad(bf2f(buf[(size_t)row * 1024 + col]), d)) atomicOr(fail + 2 + g, 1u);
        } else { const int t = col >> 7, w = col & 127; const float o = dot_bf(xr, W1 + (size_t)(7168 + t * 256 + w) * 1024, 1024), z = dot_bf(xr, W1 + (size_t)(7168 + t * 256 + 128 + w) * 1024, 1024);
            if (bad(bf2f(((const bf16*)args.out + (size_t)M * DM)[(size_t)row * 1024 + col]), sigm(o) * z * sigm(z))) atomicOr(fail + 9, 1u); }
    } else if (which == 2) {
        const int g = (hsh >> 8) & 1; const float d = dot_bf(XN + (size_t)row * 1024, (const bf16*)(ws + WS_WG) + (size_t)(g * 1024 + col) * 1024, 1024) + args.in[10][g * 1024 + col];
        if (bad(bf2f(((const bf16*)(ws + WS_BK) + (size_t)g * (BUF / 2))[(size_t)row * 1024 + col]), sigm(d))) atomicOr(fail + 10 + g, 1u);
    } else if (which == 3) {
        const bf16* ya = (const bf16*)(ws + WS_BQ) + (size_t)row * 1024; const bf16* ym = (const bf16*)args.out + (size_t)M * DM + (size_t)row * 1024; const bf16* WP = (const bf16*)(ws + WS_WP);
        const float ga = bf2f(((const bf16*)(ws + WS_BK))[(size_t)row * 1024 + col]), gm = bf2f(((const bf16*)(ws + WS_BV))[(size_t)row * 1024 + col]);
        const float ref = ga * dot_bf(ya, WP + (size_t)col * 1024, 1024) + gm * dot_bf(ym, WP + (size_t)(1024 + col) * 1024, 1024);
        if (bad(bf2f(((const bf16*)(ws + WS_MQ))[(size_t)row * 1024 + col]), ref)) atomicOr(fail + 12, 1u);
    } else if (which == 4) {
        const float ref = args.in[0][(size_t)row * 1024 + col] + dot_bf((const bf16*)(ws + WS_MQ) + (size_t)row * 1024, (const bf16*)(ws + WS_WO) + (size_t)col * 1024, 1024);
        if (bad(args.out[(size_t)row * 1024 + col], ref)) atomicOr(fail + 13, 1u);
    }
}
__global__ void __launch_bounds__(256) report_kernel(Args args) {
    const unsigned* fail = (const unsigned*)(args.ws + WS_CTL) + 1024; int code = 0;
    for (int i = 13; i >= 0; --i) if (fail[i]) code = i + 1;
    if (code == 0) return;
    for (size_t i = (size_t)blockIdx.x * 256 + threadIdx.x; i < (size_t)M * DM; i += (size_t)gridDim.x * 256) args.out[i] = (float)code;
}

extern "C" void kernel_launch(void* const* d_in, const int* in_sizes, int n_in, void* d_out, int out_size, void* d_ws, size_t ws_size, hipStream_t stream) {
    static int grid = 0;
    if (grid == 0) {
        if (n_in != 15 || out_size != M * DM || ws_size < WS_END) { fprintf(stderr, "kernel_launch: unexpected shapes (n_in %d out %d ws %zu)\n", n_in, out_size, ws_size); grid = -1; return; }
        int dev = 0, cus = 0;
        hipGetDevice(&dev); hipDeviceGetAttribute(&cus, hipDeviceAttributeMultiprocessorCount, dev);
        if (hipFuncSetAttribute((const void*)skel_fwd, hipFuncAttributeMaxDynamicSharedMemorySize, LDS_BYTES) != hipSuccess) { fprintf(stderr, "kernel_launch: hipFuncSetAttribute failed\n"); grid = -1; return; }
        int per_cu = 0;
        if (hipOccupancyMaxActiveBlocksPerMultiprocessor(&per_cu, (const void*)skel_fwd, NWAVES * 64, LDS_BYTES) != hipSuccess || per_cu < 1) { fprintf(stderr, "kernel_launch: occupancy query failed\n"); grid = -1; return; }
        grid = cus * per_cu;
    }
    if (grid < 0) return;
    Args a{};
    for (int i = 0; i < 15; ++i) a.in[i] = (const float*)d_in[i];
    a.out = (float*)d_out; a.ws = (unsigned char*)d_ws;
    unsigned char* ws = (unsigned char*)d_ws;
    auto run = [&](int lo, int hi) { a.ph_lo = lo; a.ph_hi = hi; hipLaunchKernelGGL(skel_fwd, dim3(grid), dim3(NWAVES * 64), LDS_BYTES, stream, a); };
    (void)hipMemsetAsync(ws + WS_CTL, 0, CTL_ZERO_BYTES, stream);
    if (ONE_LAUNCH) {
        a.ph_lo = 0; a.ph_hi = 8; void* kargs[] = {&a};
        const hipError_t e = hipLaunchCooperativeKernel((const void*)skel_fwd, dim3(grid), dim3(NWAVES * 64), kargs, LDS_BYTES, stream);
        if (e != hipSuccess) fprintf(stderr, "kernel_launch: cooperative launch failed: %s (grid %d)\n", hipGetErrorString(e), grid);
        return;
    }
#define CHK(w) do { if (SELFCHECK) hipLaunchKernelGGL(chk_kernel, dim3(256), dim3(256), 0, stream, (w), a); } while (0)
    run(0, 1); CHK(0); run(1, 2); CHK(1);
    run(2, 3);
    run(4, 5); run(6, 7); run(7, 8);
}
```
